# Optimizing an MI355X kernel written in HIP

```python
import jax
import jax.numpy as jnp
from jax import lax
import numpy as np

D_MODEL = 2048
BATCH = 16
SEQ = 2048
DEPTH = 4
DEC_BATCH = 8
DEC_SEQ = 64
PAST_LEN = 4096

CHUNK = 64
Q_BLOCK = 128
SUB = 16
N_SUB = CHUNK // SUB
N_EVEN = (DEPTH + 1) // 2
N_ODD = DEPTH // 2
EPS = 1e-6

D_CONV = D_MODEL // 2
CONV_W = 3

MLA_HEADS = 8
Q_LORA = 512
KV_LORA = 512
NOPE_DIM = 128
ROPE_DIM = 64
V_DIM = 128
ROPE_THETA = 10000.0
MLA_SCALE = (NOPE_DIM + ROPE_DIM) ** -0.5

HG_HEADS = 16
HG_DK = 128
HG_DV = 128

D_FF = 5632

D_IN_A = 3 * D_CONV + Q_LORA + KV_LORA + ROPE_DIM
D_CAT_A = D_CONV + MLA_HEADS * V_DIM
D_IN_C = 2 * HG_HEADS * HG_DK + 2 * HG_HEADS * HG_DV

kernel_name = 'streaming_conv_mla_hgrn2_macaron'


def _rmsnorm(x, g):
    xf = x.astype(jnp.float32)
    y = xf * lax.rsqrt(jnp.mean(xf * xf, axis=-1, keepdims=True) + EPS)
    return (y * g.astype(jnp.float32)).astype(x.dtype)


def _swiglu(h, w_gate, w_up, w_down):
    return (jax.nn.silu(h @ w_gate) * (h @ w_up)) @ w_down


def _rope(x, pos):
    half = ROPE_DIM // 2
    inv = ROPE_THETA ** (-jnp.arange(half, dtype=jnp.float32) / half)
    ang = pos.astype(jnp.float32)[:, None] * inv[None, :]
    shape = (ang.shape[0],) + (1,) * (x.ndim - 3) + (half,)
    cos = jnp.cos(ang).reshape(shape)
    sin = jnp.sin(ang).reshape(shape)
    xf = x.astype(jnp.float32)
    x1, x2 = xf[..., :half], xf[..., half:]
    return jnp.concatenate([x1 * cos - x2 * sin, x1 * sin + x2 * cos], axis=-1).astype(x.dtype)


def _causal_dwconv(v, prev, w):
    t = v.shape[1]
    vp = jnp.concatenate([prev, v], axis=1)
    y = vp[:, 0:t] * w[0]
    for j in range(1, CONV_W):
        y = y + vp[:, j:j + t] * w[j]
    return y, vp[:, -(CONV_W - 1):]


def _mla_attend(q_lat, q_pe, c_kv, k_pe, mask):
    s = jnp.einsum('bthc,bsc->bhts', q_lat, c_kv, preferred_element_type=jnp.float32)
    s = s + jnp.einsum('bthr,bsr->bhts', q_pe, k_pe, preferred_element_type=jnp.float32)
    s = s * MLA_SCALE
    if mask is not None:
        s = jnp.where(mask, s, -jnp.inf)
    p = jax.nn.softmax(s, axis=-1).astype(c_kv.dtype)
    return jnp.einsum('bhts,bsc->bthc', p, c_kv)


def _mla_prompt(q_lat, q_pe, c_kv, k_pe):
    t = q_lat.shape[1]
    outs = []
    for q0 in range(0, t, Q_BLOCK):
        q1 = min(q0 + Q_BLOCK, t)
        q_chunk = jnp.arange(q0, q1) // CHUNK
        k_chunk = jnp.arange(q1) // CHUNK
        mask = k_chunk[None, :] <= q_chunk[:, None]
        outs.append(_mla_attend(q_lat[:, q0:q1], q_pe[:, q0:q1], c_kv[:, :q1], k_pe[:, :q1], mask))
    return jnp.concatenate(outs, axis=1)


def _conv_mla_mixer(h, pos, conv_prev, ckv_prev, kpe_prev, w_in, w_conv, g_q, w_uq, g_kv, w_ukv, w_out):
    b, t, _ = h.shape
    z = h @ w_in
    o1, o2, o3 = D_CONV, 2 * D_CONV, 3 * D_CONV
    o4, o5 = o3 + Q_LORA, o3 + Q_LORA + KV_LORA
    gate_b, gate_c, u = z[..., :o1], z[..., o1:o2], z[..., o2:o3]
    c_q, c_kv, k_pe = z[..., o3:o4], z[..., o4:o5], z[..., o5:]
    if conv_prev is None:
        conv_prev = jnp.zeros((b, CONV_W - 1, D_CONV), h.dtype)
    conv, conv_state = _causal_dwconv(gate_c * u, conv_prev, w_conv)
    y_a = gate_b * conv
    q = (_rmsnorm(c_q, g_q) @ w_uq).reshape(b, t, MLA_HEADS, NOPE_DIM + ROPE_DIM)
    q_nope, q_pe = q[..., :NOPE_DIM], _rope(q[..., NOPE_DIM:], pos)
    c_kv = _rmsnorm(c_kv, g_kv)
    k_pe = _rope(k_pe, pos)
    w_ukv = w_ukv.reshape(KV_LORA, MLA_HEADS, NOPE_DIM + V_DIM)
    q_lat = jnp.einsum('bthn,chn->bthc', q_nope, w_ukv[..., :NOPE_DIM])
    if ckv_prev is None:
        o_lat = _mla_prompt(q_lat, q_pe, c_kv, k_pe)
    else:
        keys_c = jnp.concatenate([ckv_prev, c_kv], axis=1)
        keys_r = jnp.concatenate([kpe_prev, k_pe], axis=1)
        o_lat = _mla_attend(q_lat, q_pe, keys_c, keys_r, None)
    y_b = jnp.einsum('bthc,chv->bthv', o_lat, w_ukv[..., NOPE_DIM:]).reshape(b, t, MLA_HEADS * V_DIM)
    y = jnp.concatenate([y_a, y_b], axis=-1) @ w_out
    return y, conv_state, c_kv, k_pe


def _gla_chunk_step(S, inp):
    q, k, v, g = inp
    b, h, c, dk = q.shape
    A = jnp.cumsum(g, axis=2)
    Ar = A.reshape(b, h, N_SUB, SUB, dk)
    qr = q.reshape(b, h, N_SUB, SUB, dk)
    kr = k.reshape(b, h, N_SUB, SUB, dk)
    vr = v.reshape(b, h, N_SUB, SUB, v.shape[-1])
    A_end = Ar[:, :, :, -1]
    tril_sub = jnp.tril(jnp.ones((SUB, SUB), jnp.float32))
    strict = jnp.tril(jnp.ones((N_SUB, N_SUB), jnp.float32), -1)
    dec = jnp.exp(jnp.minimum(Ar[:, :, :, :, None] - Ar[:, :, :, None], 0.0))
    s_diag = jnp.einsum('bhntd,bhnsd,bhntsd->bhnts', qr, kr, dec) * tril_sub
    k_end = kr * jnp.exp(A_end[:, :, :, None] - Ar)
    q_rel = qr[:, :, :, :, None] * jnp.exp(jnp.minimum(Ar[:, :, :, :, None] - A_end[:, :, None, None], 0.0))
    s_off = jnp.einsum('bhitjd,bhjsd->bhitjs', q_rel, k_end) * strict[:, None, :, None]
    o = jnp.einsum('bhnts,bhnse->bhnte', s_diag, vr) + jnp.einsum('bhitjs,bhjse->bhite', s_off, vr)
    o = o.reshape(b, h, c, -1) + jnp.einsum('bhcd,bhde->bhce', q * jnp.exp(A), S)
    A_last = A[:, :, -1]
    S_new = jnp.exp(A_last)[..., None] * S + jnp.einsum('bhcd,bhce->bhde', k * jnp.exp(A_last[:, :, None] - A), v)
    return S_new, o


def _gla_scan(q, k, v, g, S0):
    b, h, t, _ = q.shape
    nc = t // CHUNK

    def split(a):
        return jnp.moveaxis(a.reshape(b, h, nc, CHUNK, a.shape[-1]), 2, 0)

    S, o = lax.scan(_gla_chunk_step, S0, (split(q), split(k), split(v), split(g)))
    o = jnp.moveaxis(o, 0, 2).reshape(b, h, t, -1)
    return o, S


def _hgrn2_mixer(h, S0, lb, w_in, g_o, w_out):
    b, t, _ = h.shape
    dk = HG_HEADS * HG_DK
    dv = HG_HEADS * HG_DV
    z = h @ w_in
    zq, zf = z[..., :dk], z[..., dk:2 * dk].astype(jnp.float32)
    zi, zg = z[..., 2 * dk:2 * dk + dv], z[..., 2 * dk + dv:]
    g = jnp.log(lb + (1.0 - lb) * jax.nn.sigmoid(zf))
    k = (1.0 - lb) * jax.nn.sigmoid(-zf)
    q = jax.nn.silu(zq.astype(jnp.float32))
    v = zi.astype(jnp.float32)
    pad = (-t) % CHUNK

    def heads(a):
        a = a.reshape(b, t, HG_HEADS, -1).transpose(0, 2, 1, 3)
        return jnp.pad(a, ((0, 0), (0, 0), (0, pad), (0, 0)))

    o, S = _gla_scan(heads(q), heads(k), heads(v), heads(g), S0)
    o = o[:, :, :t].transpose(0, 2, 1, 3)
    o = _rmsnorm(o, g_o) * jax.nn.silu(zg.astype(jnp.float32).reshape(b, t, HG_HEADS, HG_DV))
    y = o.reshape(b, t, dv).astype(h.dtype) @ w_out
    return y, S


def _run_group(x, pos, conv_prev, ckv_prev, kpe_prev, hgrn_prev, p):
    b = x.shape[0]
    lb_sm = jax.nn.softmax(p['lb_logits'].astype(jnp.float32), axis=0)
    lb_all = jnp.cumsum(lb_sm, axis=0) - lb_sm[0]
    conv_new, ckv_new, kpe_new, hgrn_new = [], [], [], []
    for l in range(DEPTH):
        x = x + 0.5 * _swiglu(_rmsnorm(x, p['norm_ffn1'][l]), p['w_ffn1_gate'][l], p['w_ffn1_up'][l], p['w_ffn1_down'][l])
        hn = _rmsnorm(x, p['norm_mix'][l])
        if l % 2 == 0:
            e = l // 2
            y, cs, ckv, kpe = _conv_mla_mixer(
                hn, pos,
                None if conv_prev is None else conv_prev[e],
                None if ckv_prev is None else ckv_prev[e],
                None if kpe_prev is None else kpe_prev[e],
                p['w_in_a'][e], p['w_conv'][e], p['g_q'][e], p['w_uq'][e],
                p['g_kv'][e], p['w_ukv'][e], p['w_out_a'][e])
            conv_new.append(cs)
            ckv_new.append(ckv)
            kpe_new.append(kpe)
        else:
            o = l // 2
            if hgrn_prev is None:
                S0 = jnp.zeros((b, HG_HEADS, HG_DK, HG_DV), jnp.float32)
            else:
                S0 = hgrn_prev[o].astype(jnp.float32)
            y, S = _hgrn2_mixer(hn, S0, lb_all[o], p['w_in_c'][o], p['g_o'][o], p['w_out_c'][o])
            hgrn_new.append(S.astype(x.dtype))
        x = x + y
        x = x + 0.5 * _swiglu(_rmsnorm(x, p['norm_ffn2'][l]), p['w_ffn2_gate'][l], p['w_ffn2_up'][l], p['w_ffn2_down'][l])
    y_out = _rmsnorm(x, p['norm_final'])
    return y_out, jnp.stack(conv_new), jnp.stack(ckv_new), jnp.stack(kpe_new), jnp.stack(hgrn_new)


def setup_inputs(seed: int = 0) -> dict:
    key = jax.random.key(seed)
    it = iter(jax.random.split(key, 40))
    f32 = jnp.float32

    def nrm(shape, fan_in):
        return jax.random.normal(next(it), shape, f32) * (fan_in ** -0.5)

    def gain(shape):
        return 1.0 + 0.02 * jax.random.normal(next(it), shape, f32)

    return {
        'x_prompt': jax.random.normal(next(it), (BATCH, SEQ, D_MODEL), f32),
        'x_sample': jax.random.normal(next(it), (DEC_BATCH, DEC_SEQ, D_MODEL), f32),
        'cache_conv': jax.random.normal(next(it), (N_EVEN, DEC_BATCH, CONV_W - 1, D_CONV), f32),
        'cache_ckv': jax.random.normal(next(it), (N_EVEN, DEC_BATCH, PAST_LEN, KV_LORA), f32),
        'cache_kpe': jax.random.normal(next(it), (N_EVEN, DEC_BATCH, PAST_LEN, ROPE_DIM), f32),
        'state_hgrn': 0.5 * jax.random.normal(next(it), (N_ODD, DEC_BATCH, HG_HEADS, HG_DK, HG_DV), f32),
        'norm_ffn1': gain((DEPTH, D_MODEL)),
        'w_ffn1_gate': nrm((DEPTH, D_MODEL, D_FF), D_MODEL),
        'w_ffn1_up': nrm((DEPTH, D_MODEL, D_FF), D_MODEL),
        'w_ffn1_down': nrm((DEPTH, D_FF, D_MODEL), D_FF),
        'norm_mix': gain((DEPTH, D_MODEL)),
        'w_in_a': nrm((N_EVEN, D_MODEL, D_IN_A), D_MODEL),
        'w_conv': nrm((N_EVEN, CONV_W, D_CONV), CONV_W),
        'g_q': gain((N_EVEN, Q_LORA)),
        'w_uq': nrm((N_EVEN, Q_LORA, MLA_HEADS * (NOPE_DIM + ROPE_DIM)), Q_LORA),
        'g_kv': gain((N_EVEN, KV_LORA)),
        'w_ukv': nrm((N_EVEN, KV_LORA, MLA_HEADS * (NOPE_DIM + V_DIM)), KV_LORA),
        'w_out_a': nrm((N_EVEN, D_CAT_A, D_MODEL), D_CAT_A),
        'w_in_c': nrm((N_ODD, D_MODEL, D_IN_C), D_MODEL),
        'lb_logits': 0.1 * jax.random.normal(next(it), (N_ODD, HG_HEADS * HG_DK), f32),
        'g_o': gain((N_ODD, HG_DV)),
        'w_out_c': nrm((N_ODD, HG_HEADS * HG_DV, D_MODEL), HG_HEADS * HG_DV),
        'norm_ffn2': gain((DEPTH, D_MODEL)),
        'w_ffn2_gate': nrm((DEPTH, D_MODEL, D_FF), D_MODEL),
        'w_ffn2_up': nrm((DEPTH, D_MODEL, D_FF), D_MODEL),
        'w_ffn2_down': nrm((DEPTH, D_FF, D_MODEL), D_FF),
        'norm_final': gain((D_MODEL,)),
    }


def reference(x_prompt, x_sample, cache_conv, cache_ckv, cache_kpe, state_hgrn,
              norm_ffn1, w_ffn1_gate, w_ffn1_up, w_ffn1_down, norm_mix,
              w_in_a, w_conv, g_q, w_uq, g_kv, w_ukv, w_out_a,
              w_in_c, lb_logits, g_o, w_out_c,
              norm_ffn2, w_ffn2_gate, w_ffn2_up, w_ffn2_down, norm_final):
    params = {
        'norm_ffn1': norm_ffn1, 'w_ffn1_gate': w_ffn1_gate, 'w_ffn1_up': w_ffn1_up, 'w_ffn1_down': w_ffn1_down,
        'norm_mix': norm_mix,
        'w_in_a': w_in_a, 'w_conv': w_conv, 'g_q': g_q, 'w_uq': w_uq, 'g_kv': g_kv, 'w_ukv': w_ukv, 'w_out_a': w_out_a,
        'w_in_c': w_in_c, 'lb_logits': lb_logits, 'g_o': g_o, 'w_out_c': w_out_c,
        'norm_ffn2': norm_ffn2, 'w_ffn2_gate': w_ffn2_gate, 'w_ffn2_up': w_ffn2_up, 'w_ffn2_down': w_ffn2_down,
        'norm_final': norm_final,
    }
    pos_p = jnp.arange(x_prompt.shape[1], dtype=jnp.int32)
    pos_s = cache_ckv.shape[2] + jnp.arange(x_sample.shape[1], dtype=jnp.int32)
    y_prompt, conv_p, ckv_p, kpe_p, hgrn_p = _run_group(x_prompt, pos_p, None, None, None, None, params)
    y_sample, conv_s, ckv_s, kpe_s, hgrn_s = _run_group(x_sample, pos_s, cache_conv, cache_ckv, cache_kpe, state_hgrn, params)
    return (y_prompt, y_sample, conv_p, ckv_p, kpe_p, hgrn_p, conv_s, ckv_s, kpe_s, hgrn_s)
```

```cpp
#include <hip/hip_runtime.h>
#include <cstdio>
#include <cstdint>
namespace pg8 {
#define PG8_LAS __attribute__((address_space(3)))
typedef unsigned short bf16_t;
typedef short bf16x8 __attribute__((ext_vector_type(8)));
typedef float f32x4 __attribute__((ext_vector_type(4)));
typedef unsigned u32x4 __attribute__((ext_vector_type(4)));
constexpr int BM = 256, BK = 64, HALF = 128, HTB = HALF * BK * 2  , STAGE_BYTES = 8 * HTB, NXCD = 8, WGM = 8;

__host__ __device__ __forceinline__ int lds_byte(int r, int c) { const int st = (r >> 4) * 2 + (c >> 5), rr = r & 15, cc = c & 31, ob = rr * 64 + cc * 2; return st * 1024 + (ob ^ (((ob >> 9) & 1) << 5)); }
__host__ __device__ __forceinline__ void stage_rc(int b, int& R, int& C) { const int st = b / 1024, sb = b % 1024, swz = sb ^ (((sb >> 9) & 1) << 5); R = (st >> 1) * 16 + swz / 64; C = (st & 1) * 32 + (swz % 64) / 2; }
__host__ __device__ __forceinline__ int perm32(int rho) { const int n = rho >> 4, i = rho & 15; return 8 * (i >> 2) + 4 * n + (i & 3); }

struct Unit { int pm, pn; };
struct Gemm { const bf16_t* A; const bf16_t* Bt; int M, N, K, lda, ldb; };

struct StaticOrder {
    int nM, nN, nwg, G, c;
    __host__ __device__ void init(int M, int N, int G_, int c_) { nM = M / BM; nN = N / BM; nwg = nM * nN; G = G_; c = c_; }
    __host__ __device__ bool next(int i, Unit& u) const {
        const long L = (long)i * G + c; if (L >= nwg) return false;
        int wgid = (int)L; { const int q = nwg / NXCD, r = nwg % NXCD, xcd = wgid % NXCD, off = wgid / NXCD; wgid = (xcd < r ? xcd * (q + 1) : r * (q + 1) + (xcd - r) * q) + off; }
        const int nig = WGM * nN, gid = wgid / nig, fm = gid * WGM, gsz = (nM - fm) < WGM ? (nM - fm) : WGM;
        u.pm = fm + ((wgid % nig) % gsz); u.pn = (wgid % nig) / gsz; return true;
    }
    __device__ __forceinline__ void a_ready(const Unit&) const {}
    __device__ __forceinline__ void done(const Unit&) const {}
};

typedef float f32x2_t __attribute__((ext_vector_type(2))); typedef __bf16 bf16x2_t __attribute__((ext_vector_type(2)));
__device__ __forceinline__ unsigned cvt_pk_bf16(float lo, float hi) { const f32x2_t v = {lo, hi}; const bf16x2_t b = __builtin_convertvector(v, bf16x2_t); return __builtin_bit_cast(unsigned, b); }
typedef float f32x2 __attribute__((ext_vector_type(2)));
__device__ __forceinline__ float fast_sigmoid(float x) { return __builtin_amdgcn_rcpf(1.0f + __builtin_amdgcn_exp2f(-1.44269504089f * x)); }
__device__ __forceinline__ float fast_silu(float x) { return x * fast_sigmoid(x); }

typedef float ssq_t;
__device__ __forceinline__ float row_rstd(const ssq_t* ssp, int row) { const f32x4 a = *(const f32x4*)(ssp + (size_t)row * 8), b = *(const f32x4*)(ssp + (size_t)row * 8 + 4);
    return __builtin_amdgcn_rsqf((((a[0] + a[1]) + (a[2] + a[3])) + ((b[0] + b[1]) + (b[2] + b[3]))) * (1.0f / 2048.0f) + 1e-6f); }

struct RsRaw { f32x4 a, b; };
__device__ __forceinline__ RsRaw rs_issue(const ssq_t* ssp, const Unit& u, int wid, int lane) { RsRaw r; const ssq_t* p = ssp + (size_t)(u.pm * BM + wid * 32 + (lane & 31)) * 8; r.a = *(const f32x4*)p; r.b = *(const f32x4*)(p + 4); return r; }
__device__ __forceinline__ void rs_finish(const RsRaw& r, PG8_LAS float* rsbuf, int wid, int lane) { const f32x4 a = r.a, b = r.b;
    const float rs = __builtin_amdgcn_rsqf((((a[0] + a[1]) + (a[2] + a[3])) + ((b[0] + b[1]) + (b[2] + b[3]))) * (1.0f / 2048.0f) + 1e-6f); if (lane < 32) rsbuf[wid * 32 + lane] = rs; }
struct NoRaw {};

struct EpiStore {
    static constexpr bool PERM = true, AFTER_DRAIN = false;
    bf16_t* O; int ldc; const ssq_t* ss;
    typedef RsRaw Raw;
    __device__ __forceinline__ Raw issue(const Unit& u, int wid, int lane) const { if (ss) return rs_issue(ss, u, wid, lane); return Raw{(f32x4){0.f, 0.f, 0.f, 0.f}, (f32x4){0.f, 0.f, 0.f, 0.f}}; }
    __device__ __forceinline__ void finish(const Raw& r, PG8_LAS float* rsbuf, int wid, int lane) const { if (ss) rs_finish(r, rsbuf, wid, lane); }
    __device__ __forceinline__ void operator()(const f32x4 (&acc)[2][2][4][2], const Unit& u, int wr, int wc, int fr, int fq, const PG8_LAS float* rsbuf) const {
        const int row0 = u.pm * BM + wr * 64 + fr, col0 = u.pn * BM + wc * 32 + 8 * fq;
#pragma unroll
        for (int ai = 0; ai < 2; ++ai)
#pragma unroll
            for (int m = 0; m < 4; ++m) { const int row = row0 + ai * HALF + m * 16; bf16_t* rowp = O + (size_t)row * ldc + col0; const float rs = ss ? rsbuf[ai * HALF + wr * 64 + m * 16 + fr] : 1.0f;
#pragma unroll
                for (int bj = 0; bj < 2; ++bj) { const f32x4 v0 = acc[ai][bj][m][0] * rs, v1 = acc[ai][bj][m][1] * rs;
                    u32x4 w; w.x = cvt_pk_bf16(v0[0], v0[1]); w.y = cvt_pk_bf16(v0[2], v0[3]); w.z = cvt_pk_bf16(v1[0], v1[1]); w.w = cvt_pk_bf16(v1[2], v1[3]);
                    *(u32x4*)(rowp + bj * HALF) = w; } }
    }
};
struct EpiSwiGLU {
    static constexpr bool PERM = true, AFTER_DRAIN = false;
    bf16_t* O; int ldc; const ssq_t* ss;
    typedef RsRaw Raw;
    __device__ __forceinline__ Raw issue(const Unit& u, int wid, int lane) const { return rs_issue(ss, u, wid, lane); }
    __device__ __forceinline__ void finish(const Raw& r, PG8_LAS float* rsbuf, int wid, int lane) const { rs_finish(r, rsbuf, wid, lane); }
    __device__ __forceinline__ void operator()(const f32x4 (&acc)[2][2][4][2], const Unit& u, int wr, int wc, int fr, int fq, const PG8_LAS float* rsbuf) const {
        const int row0 = u.pm * BM + wr * 64 + fr, col0 = u.pn * HALF + wc * 32 + 8 * fq;
#pragma unroll
        for (int ai = 0; ai < 2; ++ai)
#pragma unroll
            for (int m = 0; m < 4; ++m) { const int row = row0 + ai * HALF + m * 16; bf16_t* rowp = O + (size_t)row * ldc + col0; const float rs = rsbuf[ai * HALF + wr * 64 + m * 16 + fr];
                f32x4 h0, h1;
#pragma unroll
                for (int j = 0; j < 4; ++j) { h0[j] = fast_silu(acc[ai][0][m][0][j] * rs) * (acc[ai][1][m][0][j] * rs); h1[j] = fast_silu(acc[ai][0][m][1][j] * rs) * (acc[ai][1][m][1][j] * rs); }
                u32x4 w; w.x = cvt_pk_bf16(h0[0], h0[1]); w.y = cvt_pk_bf16(h0[2], h0[3]); w.z = cvt_pk_bf16(h1[0], h1[1]); w.w = cvt_pk_bf16(h1[2], h1[3]);
                *(u32x4*)rowp = w; }
    }
};
struct EpiResidNorm {
    static constexpr bool PERM = true, AFTER_DRAIN = false;
    float* X; bf16_t* XB; ssq_t* ss; int ldc; float scale; PG8_LAS float* P;
    typedef NoRaw Raw;
    __device__ __forceinline__ Raw issue(const Unit&, int, int) const { return Raw{}; }
    __device__ __forceinline__ void finish(const Raw&, PG8_LAS float*, int, int) const {}
    __device__ __forceinline__ void operator()(const f32x4 (&acc)[2][2][4][2], const Unit& u, int wr, int wc, int fr, int fq, const PG8_LAS float*) const {
        const int row0 = u.pm * BM + wr * 64 + fr, col0 = u.pn * BM + wc * 32 + 8 * fq;
#pragma unroll
        for (int ai = 0; ai < 2; ++ai) {
            f32x4 xv[4][2][2];
#pragma unroll
            for (int m = 0; m < 4; ++m) { const float* rowp = X + (size_t)(row0 + ai * HALF + m * 16) * ldc + col0;
#pragma unroll
                for (int bj = 0; bj < 2; ++bj)
#pragma unroll
                    for (int n = 0; n < 2; ++n) xv[m][bj][n] = *(const f32x4*)(rowp + bj * HALF + 4 * n); }
#pragma unroll
            for (int m = 0; m < 4; ++m) { const int row = row0 + ai * HALF + m * 16; float* rowp = X + (size_t)row * ldc + col0; float q = 0.f;
#pragma unroll
                for (int bj = 0; bj < 2; ++bj) { const f32x4 v0 = xv[m][bj][0] + acc[ai][bj][m][0] * scale, v1 = xv[m][bj][1] + acc[ai][bj][m][1] * scale;
                    *(f32x4*)(rowp + bj * HALF) = v0; *(f32x4*)(rowp + bj * HALF + 4) = v1;
                    q += ((v0[0] * v0[0] + v0[1] * v0[1]) + (v0[2] * v0[2] + v0[3] * v0[3])) + ((v1[0] * v1[0] + v1[1] * v1[1]) + (v1[2] * v1[2] + v1[3] * v1[3]));
                    if (XB) { u32x4 w; w.x = cvt_pk_bf16(v0[0], v0[1]); w.y = cvt_pk_bf16(v0[2], v0[3]); w.z = cvt_pk_bf16(v1[0], v1[1]); w.w = cvt_pk_bf16(v1[2], v1[3]); *(u32x4*)(XB + (size_t)row * ldc + col0 + bj * HALF) = w; } }
                if (XB) { q += __shfl_xor(q, 16); q += __shfl_xor(q, 32); if (fq == 0) P[(ai * HALF + wr * 64 + m * 16 + fr) * 4 + wc] = q; } }
            asm volatile("" ::: "memory"); }
        if (XB) {
            asm volatile("s_waitcnt lgkmcnt(0)" ::: "memory"); __builtin_amdgcn_s_barrier(); asm volatile("" ::: "memory");
            const int lane = fr + 16 * fq, r = (wr * 4 + wc) * 32 + lane;
            if (lane < 32) { const f32x4 p = *(const PG8_LAS f32x4*)(P + r * 4); ss[(size_t)(u.pm * BM + r) * 8 + u.pn] = (p[0] + p[1]) + (p[2] + p[3]); }
        }
    }
};
struct EpiGla {
    static constexpr bool PERM = true, AFTER_DRAIN = false;
    bf16_t* O; int ldc; const float* lb; const ssq_t* ss;
    typedef RsRaw Raw;
    __device__ __forceinline__ Raw issue(const Unit& u, int wid, int lane) const { return rs_issue(ss, u, wid, lane); }
    __device__ __forceinline__ void finish(const Raw& r, PG8_LAS float* rsbuf, int wid, int lane) const { rs_finish(r, rsbuf, wid, lane); }
    __device__ __forceinline__ void operator()(const f32x4 (&acc)[2][2][4][2], const Unit& u, int wr, int wc, int fr, int fq, const PG8_LAS float* rsbuf) const {
        const int row0 = u.pm * BM + wr * 64 + fr, col0 = u.pn * BM + wc * 32 + 8 * fq;
        const int sec = u.pn >> 3;
        f32x4 lbv[2][2];
#pragma unroll
        for (int bj = 0; bj < 2; ++bj)
#pragma unroll
            for (int n = 0; n < 2; ++n) lbv[bj][n] = (sec == 1) ? *(const f32x4*)(lb + (col0 - 2048) + bj * HALF + 4 * n) : (f32x4){0.f, 0.f, 0.f, 0.f};
#pragma unroll
        for (int ai = 0; ai < 2; ++ai)
#pragma unroll
            for (int m = 0; m < 4; ++m) { const int row = row0 + ai * HALF + m * 16; bf16_t* rowp = O + (size_t)row * ldc + col0; const float rs = rsbuf[ai * HALF + wr * 64 + m * 16 + fr];
#pragma unroll
                for (int bj = 0; bj < 2; ++bj) { f32x4 v[2] = {acc[ai][bj][m][0] * rs, acc[ai][bj][m][1] * rs};
                    if (sec == 0 || sec == 3) {
#pragma unroll
                        for (int n = 0; n < 2; ++n)
#pragma unroll
                            for (int j = 0; j < 4; ++j) v[n][j] = fast_silu(v[n][j]);
                    } else if (sec == 1) {
#pragma unroll
                        for (int n = 0; n < 2; ++n)
#pragma unroll
                            for (int j = 0; j < 4; ++j) { const float l = lbv[bj][n][j]; v[n][j] = 0.69314718056f * __builtin_amdgcn_logf(l + (1.0f - l) * fast_sigmoid(v[n][j])); }
                    }
                    u32x4 w; w.x = cvt_pk_bf16(v[0][0], v[0][1]); w.y = cvt_pk_bf16(v[0][2], v[0][3]); w.z = cvt_pk_bf16(v[1][0], v[1][1]); w.w = cvt_pk_bf16(v[1][2], v[1][3]);
                    *(u32x4*)(rowp + bj * HALF) = w; } }
    }
};

template <class Epi, class Sched, bool ALIGN_EPI = false, bool SP2 = false>
__device__ __forceinline__ void gemm_phase(PG8_LAS unsigned char* lds, const Gemm g, const Sched& S, const Epi& E) {
    int tid_ = threadIdx.x; asm volatile("" : "+v"(tid_));
    const int tid = tid_, wid = __builtin_amdgcn_readfirstlane(tid >> 6), lane = tid & 63, wr = wid >> 2, wc = wid & 3, fr = lane & 15, fq = lane >> 4;
    const int K = g.K, nt = K / BK;
    unsigned voffA[2], voffB[2];
#pragma unroll
    for (int i = 0; i < 2; ++i) { int R, C; stage_rc(tid * 16 + i * 8192, R, C); const int Rb = Epi::PERM ? ((R & ~31) + perm32(R & 31)) : R;
        voffA[i] = (unsigned)(R * g.lda + C) * 2u; voffB[i] = (unsigned)(Rb * g.ldb + C) * 2u; }
    const size_t kstep = (size_t)(BK * 2);
    const size_t hstepA = (size_t)HALF * g.lda * 2, hstepB = (size_t)HALF * g.ldb * 2;
    const size_t tstepA = 2 * hstepA, tstepB = 2 * hstepB;
    const unsigned ldsw = (unsigned)wid * 1024u;
    const int aoff = lds_byte(wr * 64 + fr, fq * 8), boff = lds_byte(wc * 32 + fr, fq * 8);
#define PG8_SA(b, h) (((b) * 2 + (h)) * HTB)
#define PG8_SB(b, h) ((4 + (b) * 2 + (h)) * HTB)
#define PG8_STAGE(bufoff, gbase, voff) do { _Pragma("unroll") for (int _i = 0; _i < 2; ++_i) \
        __builtin_amdgcn_global_load_lds((const unsigned*)((const char*)(gbase) + (voff)[_i]), (PG8_LAS unsigned*)(lds + (bufoff) + ldsw + _i * 8192), 16, 0, 0); } while (0)
#define PG8_LDA(dst, b, h) do { _Pragma("unroll") for (int m = 0; m < 4; ++m) _Pragma("unroll") for (int k = 0; k < 2; ++k) dst[m][k] = *(const PG8_LAS bf16x8*)(lds + PG8_SA(b, h) + aoff + m * 2048 + k * 1024); } while (0)
#define PG8_LDB(dst, b, h) do { _Pragma("unroll") for (int n = 0; n < 2; ++n) _Pragma("unroll") for (int k = 0; k < 2; ++k) dst[n][k] = *(const PG8_LAS bf16x8*)(lds + PG8_SB(b, h) + boff + n * 2048 + k * 1024); } while (0)
#define PG8_MMA(ai, bj, At, Bt) do { __builtin_amdgcn_s_setprio(1); _Pragma("unroll") for (int m = 0; m < 4; ++m) _Pragma("unroll") for (int n = 0; n < 2; ++n) _Pragma("unroll") for (int k = 0; k < 2; ++k) \
        acc[ai][bj][m][n] = __builtin_amdgcn_mfma_f32_16x16x32_bf16(Bt[n][k], At[m][k], acc[ai][bj][m][n], 0, 0, 0); __builtin_amdgcn_s_setprio(0); } while (0)
#define PG8_WAIT_V(n) asm volatile("s_waitcnt vmcnt(" #n ")" ::: "memory")
#define PG8_WAIT_L(n) asm volatile("s_waitcnt lgkmcnt(" #n ")" ::: "memory")
#define PG8_BAR __builtin_amdgcn_s_barrier()
#define PG8_SCHED __builtin_amdgcn_sched_barrier(0)
    Unit cur, nxt; int ui = 0;
    if (!S.next(0, cur)) return;
    f32x4 acc[2][2][4][2];
#pragma unroll
    for (int a = 0; a < 2; ++a)
#pragma unroll
        for (int b = 0; b < 2; ++b)
#pragma unroll
            for (int m = 0; m < 4; ++m)
#pragma unroll
                for (int n = 0; n < 2; ++n) acc[a][b][m][n] = (f32x4){0.f, 0.f, 0.f, 0.f};
    bf16x8 At[4][2], B0[2][2], B1[2][2];
    const char* cA = (const char*)g.A + (size_t)cur.pm * tstepA; const char* cB = (const char*)g.Bt + (size_t)cur.pn * tstepB;
    S.a_ready(cur);
    PG8_LAS float* const rs_tab = (PG8_LAS float*)(lds + STAGE_BYTES + 256 + 4096);
    int rs_par = 0; E.finish(E.issue(cur, wid, lane), rs_tab, wid, lane);
    if constexpr (SP2) {
        PG8_STAGE(PG8_SB(0, 0), cB, voffB); PG8_STAGE(PG8_SB(0, 1), cB + hstepB, voffB); PG8_STAGE(PG8_SA(0, 0), cA, voffA); PG8_STAGE(PG8_SA(0, 1), cA + hstepA, voffA);
        if (wr == 1) PG8_BAR;
        PG8_WAIT_V(2); PG8_BAR;
        PG8_STAGE(PG8_SB(1, 0), cB + kstep, voffB); PG8_STAGE(PG8_SA(1, 0), cA + kstep, voffA); PG8_STAGE(PG8_SB(1, 1), cB + hstepB + kstep, voffB);
        PG8_WAIT_V(6); PG8_BAR;
    } else {
        PG8_STAGE(PG8_SB(0, 0), cB, voffB); PG8_STAGE(PG8_SA(0, 0), cA, voffA); PG8_STAGE(PG8_SB(0, 1), cB + hstepB, voffB); PG8_STAGE(PG8_SA(0, 1), cA + hstepA, voffA);
        if (wr == 1) PG8_BAR;
        PG8_WAIT_V(4); PG8_BAR;
        PG8_STAGE(PG8_SB(1, 0), cB + kstep, voffB); PG8_STAGE(PG8_SA(1, 0), cA + kstep, voffA); PG8_STAGE(PG8_SB(1, 1), cB + hstepB + kstep, voffB);
        PG8_WAIT_V(6); PG8_BAR;
    }
    for (;;) {
        const bool has_next = S.next(ui + 1, nxt);
        const char* nA = has_next ? (const char*)g.A + (size_t)nxt.pm * tstepA : cA; const char* nB = has_next ? (const char*)g.Bt + (size_t)nxt.pn * tstepB : cB;
        for (int t = 0; t < nt; t += 2) {
            const bool last = (t == nt - 2);
            const char* a1 = cA + (size_t)(t + 1) * kstep;
            const char* a2 = last ? nA : cA + (size_t)(t + 2) * kstep; const char* b2 = last ? nB : cB + (size_t)(t + 2) * kstep;
            const char* a3 = a2 + kstep; const char* b3 = b2 + kstep;
            if (last && has_next) S.a_ready(nxt);
            if constexpr (SP2) {
            PG8_LDB(B0, 0, 0); PG8_LDB(B1, 0, 1); PG8_SCHED; PG8_LDA(At, 0, 0); PG8_STAGE(PG8_SA(1, 1), a1 + hstepA, voffA);
            PG8_WAIT_V(8); PG8_WAIT_L(0); PG8_BAR; PG8_MMA(0, 0, At, B0); PG8_MMA(0, 1, At, B1); PG8_BAR; PG8_SCHED;
            PG8_LDA(At, 0, 1); PG8_STAGE(PG8_SB(0, 0), b2, voffB); PG8_STAGE(PG8_SB(0, 1), b2 + hstepB, voffB); PG8_STAGE(PG8_SA(0, 0), a2, voffA);
            PG8_WAIT_V(8); PG8_WAIT_L(0); PG8_BAR; PG8_MMA(1, 0, At, B0); PG8_MMA(1, 1, At, B1); PG8_BAR; PG8_SCHED;
            PG8_LDB(B0, 1, 0); PG8_LDB(B1, 1, 1); PG8_SCHED; PG8_LDA(At, 1, 0); PG8_STAGE(PG8_SA(0, 1), a2 + hstepA, voffA);
            PG8_WAIT_V(8); PG8_WAIT_L(0); PG8_BAR; PG8_MMA(0, 0, At, B0); PG8_MMA(0, 1, At, B1); PG8_BAR; PG8_SCHED;
            PG8_LDA(At, 1, 1); PG8_STAGE(PG8_SB(1, 0), b3, voffB); PG8_STAGE(PG8_SB(1, 1), b3 + hstepB, voffB); PG8_STAGE(PG8_SA(1, 0), a3, voffA);
            PG8_WAIT_V(8); PG8_WAIT_L(0); PG8_BAR; PG8_MMA(1, 0, At, B0); PG8_MMA(1, 1, At, B1); PG8_BAR; PG8_SCHED;
            } else {
            PG8_LDB(B0, 0, 0); PG8_SCHED; PG8_LDA(At, 0, 0); PG8_STAGE(PG8_SA(1, 1), a1 + hstepA, voffA);
            PG8_WAIT_L(8); PG8_BAR; PG8_WAIT_L(0); PG8_MMA(0, 0, At, B0); PG8_BAR; PG8_SCHED;
            PG8_LDB(B1, 0, 1); PG8_STAGE(PG8_SB(0, 0), b2, voffB);
            PG8_BAR; PG8_WAIT_L(0); PG8_MMA(0, 1, At, B1); PG8_BAR;
            PG8_LDA(At, 0, 1); PG8_STAGE(PG8_SA(0, 0), a2, voffA);
            PG8_BAR; PG8_WAIT_L(0); PG8_MMA(1, 0, At, B0); PG8_BAR; PG8_SCHED;
            PG8_STAGE(PG8_SB(0, 1), b2 + hstepB, voffB);
            PG8_WAIT_V(6); PG8_BAR; PG8_MMA(1, 1, At, B1); PG8_BAR;
            PG8_LDB(B0, 1, 0); PG8_SCHED; PG8_LDA(At, 1, 0); PG8_STAGE(PG8_SA(0, 1), a2 + hstepA, voffA);
            PG8_WAIT_L(8); PG8_BAR; PG8_WAIT_L(0); PG8_MMA(0, 0, At, B0); PG8_BAR; PG8_SCHED;
            PG8_LDB(B1, 1, 1); PG8_STAGE(PG8_SB(1, 0), b3, voffB);
            PG8_BAR; PG8_WAIT_L(0); PG8_MMA(0, 1, At, B1); PG8_BAR;
            PG8_LDA(At, 1, 1); PG8_STAGE(PG8_SA(1, 0), a3, voffA);
            PG8_BAR; PG8_WAIT_L(0); PG8_MMA(1, 0, At, B0); PG8_BAR; PG8_SCHED;
            PG8_STAGE(PG8_SB(1, 1), b3 + hstepB, voffB);
            PG8_WAIT_V(6); PG8_BAR; PG8_MMA(1, 1, At, B1); PG8_BAR;
            }
        }
        if constexpr (ALIGN_EPI) { if (wr == 0) PG8_BAR; }
        if constexpr (!Epi::AFTER_DRAIN) { typename Epi::Raw raw = E.issue(has_next ? nxt : cur, wid, lane); E(acc, cur, wr, wc, fr, fq, rs_tab + rs_par * 256); rs_par ^= 1; E.finish(raw, rs_tab + rs_par * 256, wid, lane); S.done(cur); }
        if (!has_next) break;
#pragma unroll
        for (int a = 0; a < 2; ++a)
#pragma unroll
            for (int b = 0; b < 2; ++b)
#pragma unroll
                for (int m = 0; m < 4; ++m)
#pragma unroll
                    for (int n = 0; n < 2; ++n) acc[a][b][m][n] = (f32x4){0.f, 0.f, 0.f, 0.f};
        cur = nxt; cA = nA; cB = nB; ++ui;
        if constexpr (ALIGN_EPI) { if (wr == 1) PG8_BAR; }
    }
    PG8_WAIT_V(0);
    if constexpr (!ALIGN_EPI) { if (wr == 0) PG8_BAR; }
    PG8_BAR;
#undef PG8_SA
#undef PG8_SB
#undef PG8_STAGE
#undef PG8_LDA
#undef PG8_LDB
#undef PG8_MMA
#undef PG8_WAIT_V
#undef PG8_WAIT_L
#undef PG8_BAR
#undef PG8_SCHED
}
}
constexpr int D = 2048, DFF = 5632, NB = 16, SEQ = 2048, DB = 8, DSEQ = 64, PAST = 4096, DEPTH = 4;
constexpr int MP = NB * SEQ, MS = DB * DSEQ, M = MP + MS;
constexpr int KVS = PAST + DSEQ;
constexpr int KVROWS = MP + DB * KVS;
constexpr int DCONV = 1024, QL = 512, KVL = 512, ROPE = 64, NOPE = 128, VD = 128, HEADS = 8, QHD = NOPE + ROPE;
constexpr int DINA = 3 * DCONV + QL + KVL + ROPE, DINA_P = 4352, DINC = 8192, HGH = 16, HGD = 128;
constexpr float EPS = 1e-6f;
static_assert(M % 256 == 0 && KVROWS % 256 == 0 && DINA == 4160, "shapes");
constexpr size_t O_YP = 0, O_YS = O_YP + (size_t)MP * D, O_CONVP = O_YS + (size_t)MS * D, O_CKVP = O_CONVP + (size_t)2 * NB * 2 * DCONV, O_KPEP = O_CKVP + (size_t)2 * NB * SEQ * KVL,
                 O_HGP = O_KPEP + (size_t)2 * NB * SEQ * ROPE, O_CONVS = O_HGP + (size_t)2 * NB * HGH * HGD * HGD, O_CKVS = O_CONVS + (size_t)2 * DB * 2 * DCONV,
                 O_KPES = O_CKVS + (size_t)2 * DB * DSEQ * KVL, O_HGS = O_KPES + (size_t)2 * DB * DSEQ * ROPE, O_END = O_HGS + (size_t)2 * DB * HGH * HGD * HGD;
static_assert(O_END == 119177216, "output size");
enum { I_XP = 0, I_XS, I_CCONV, I_CCKV, I_CKPE, I_SHG, I_NF1, I_F1G, I_F1U, I_F1D, I_NMIX, I_WINA, I_WCONV, I_GQ, I_WUQ, I_GKV, I_WUKV, I_WOA, I_WINC, I_LB, I_GO, I_WOC, I_NF2, I_F2G, I_F2U, I_F2D, I_NFIN, N_IN };

constexpr size_t MiB = 1u << 20;
constexpr size_t WS_CTL = 0, CTL_ZERO_BYTES = 1 * MiB;
constexpr size_t WS_ROPE = 4 * MiB;
constexpr size_t WS_LB = 5 * MiB + 512 * 1024;
constexpr size_t WS_WGU = 6 * MiB;
constexpr size_t WS_WD = WS_WGU + 8 * 44 * MiB;
constexpr size_t WS_WINA = WS_WD + 8 * 22 * MiB;
constexpr size_t WS_WINC = WS_WINA + 2 * 17 * MiB;
constexpr size_t WS_WUQ = WS_WINC + 2 * 32 * MiB;
constexpr size_t WS_WUKV = WS_WUQ + 3 * MiB;
constexpr size_t WS_WOA = WS_WUKV + 4 * MiB;
constexpr size_t WS_WOC = WS_WOA + 16 * MiB;
constexpr size_t WS_XN = WS_WOC + 16 * MiB;
constexpr size_t WS_CAT = WS_XN + 130 * MiB;
constexpr size_t WS_BIG = WS_CAT + 130 * MiB;
constexpr size_t WS_H = WS_BIG;
constexpr size_t WS_ZC = WS_BIG;
constexpr size_t WS_CQN = WS_BIG;
constexpr size_t WS_KVIN = WS_BIG + 33 * MiB;
constexpr size_t WS_KPEB = WS_BIG + 98 * MiB;
constexpr size_t WS_ZA = WS_BIG + 107 * MiB;
constexpr size_t WS_QB = WS_BIG + 107 * MiB;
constexpr size_t WS_KNOPE = WS_BIG + 205 * MiB;
constexpr size_t WS_VT = WS_BIG + 384 * MiB;
constexpr size_t WS_END = WS_BIG + 520 * MiB;
constexpr size_t WS_SS = WS_END;
constexpr size_t WS_SS_BYTES = (size_t)12 * M * 8 * 4, WS_TOTAL = WS_END + 13 * MiB;
static_assert(WS_END + WS_SS_BYTES <= WS_TOTAL, "ss map");
static_assert(WS_ZA + (size_t)M * DINA_P * 2 <= WS_VT && WS_KNOPE + (size_t)KVROWS * 1024 * 2 <= WS_VT && WS_QB + (size_t)M * 1536 * 2 <= WS_KNOPE && WS_VT + (size_t)1024 * KVROWS * 2 <= WS_END, "even-layer map");
static_assert(WS_CQN + (size_t)M * 512 * 2 <= WS_KVIN && WS_KVIN + (size_t)KVROWS * 512 * 2 <= WS_KPEB && WS_KPEB + (size_t)KVROWS * 64 * 2 <= WS_ZA, "even-layer map 2");
static_assert(WS_ZC + (size_t)M * DINC * 2 <= WS_END && WS_H + (size_t)M * DFF * 2 <= WS_END, "odd/ffn map");
static_assert(WS_ROPE + (size_t)KVS * 64 * 4 <= WS_LB && WS_LB + 2 * 2048 * 4 <= WS_WGU, "ctl map");
constexpr int CW_BAR = 4096;
constexpr int CW_ATTN = 8192;
constexpr int CW_GLA = 8192 + 256;
constexpr int CW_CONV = 8192 + 512;

constexpr int RING_OFF = 0, RING_BYTES = 131072;
constexpr int MISC_OFF = RING_BYTES;
constexpr int EPI_P_OFF = RING_BYTES + 256;
constexpr int LDS_BYTES = 147456;
constexpr int NWAVES = 8, NTHR = 512;

#define GAS __attribute__((address_space(1)))
#define LAS __attribute__((address_space(3)))
typedef unsigned short bf16;
typedef unsigned v4u __attribute__((ext_vector_type(4)));
typedef unsigned v2u __attribute__((ext_vector_type(2)));
typedef float f32x4 __attribute__((ext_vector_type(4)));
typedef short bf16x8 __attribute__((ext_vector_type(8)));
#define LDS_WAIT() asm volatile("s_waitcnt lgkmcnt(0)" ::: "memory")
#define VM_WAIT() asm volatile("s_waitcnt vmcnt(0)" ::: "memory")
__device__ __forceinline__ unsigned f2bf(float f) { unsigned u = __builtin_bit_cast(unsigned, f); return (u + 0x7fffu + ((u >> 16) & 1u)) >> 16; }
__device__ __forceinline__ unsigned pk2(float lo, float hi) { return f2bf(lo) | (f2bf(hi) << 16); }
__device__ __forceinline__ float bf2f(unsigned b) { return __builtin_bit_cast(float, b << 16); }
__device__ __forceinline__ float bflo(unsigned w) { return __builtin_bit_cast(float, w << 16); }
__device__ __forceinline__ float bfhi(unsigned w) { return __builtin_bit_cast(float, w & 0xffff0000u); }
__device__ __forceinline__ float wave_sum(float v) {
#pragma unroll
    for (int o = 1; o < 64; o <<= 1) v += __shfl_xor(v, o);
    return v;
}
#define XB_TMO      128
#define XB_XCNT(j)  (256  + 64 * (j))
#define XB_XSUB(j)  (1280 + 64 * (j))
#define XB_XGEN(j)  (2304 + 64 * (j))
#define XB_TOP      3328
#define XB_TOPGEN   3392
#define XCD_BAR_WORDS 3456
#define XB_SPIN_CAP (1u << 18)

__device__ __forceinline__ unsigned xb_ld(unsigned* p)              { return __hip_atomic_load(p, __ATOMIC_RELAXED, __HIP_MEMORY_SCOPE_AGENT); }
__device__ __forceinline__ unsigned xb_add(unsigned* p, unsigned v) { return __hip_atomic_fetch_add(p, v, __ATOMIC_RELAXED, __HIP_MEMORY_SCOPE_AGENT); }
__device__ __forceinline__ unsigned xb_xcc_id() { return (unsigned)__builtin_amdgcn_s_getreg((3 << 11) | 20) & 0xFu; }
#define XB_SPIN(cond, bar) do { unsigned _sp = 0; while (cond) { __builtin_amdgcn_s_sleep(1); \
    if ((++_sp & 255u) == 0u) { if (xb_ld(&(bar)[XB_TMO])) break; if (_sp > XB_SPIN_CAP) { atomicAdd(&(bar)[XB_TMO], 1u); break; } } } } while (0)

struct XcdBarrier {
    unsigned* bar; unsigned x;
    volatile LAS unsigned* st;
};

__device__ __forceinline__ XcdBarrier xcd_barrier_post(unsigned* bar, volatile LAS unsigned* st) {
    XcdBarrier b; b.bar = bar; b.x = xb_xcc_id(); b.st = st;
    if (threadIdx.x == 0) (void)xb_add(&bar[XB_XCNT(b.x)], 1u);
    return b;
}
__device__ __forceinline__ void xcd_barrier_complete(unsigned* bar, unsigned x, unsigned& nloc, unsigned& nx) {
    const unsigned G = gridDim.x * gridDim.y * gridDim.z;
    unsigned sum, cnt, mine, sp = 0u;
    for (;;) {
        sum = 0u; cnt = 0u; mine = 0u;
#pragma unroll
        for (unsigned j = 0; j < 16; ++j) { const unsigned c = xb_ld(&bar[XB_XCNT(j)]); sum += c; cnt += (c > 0u) ? 1u : 0u; mine = (j == x) ? c : mine; }
        if (sum == G) break;
        __builtin_amdgcn_s_sleep(1);
        if ((++sp & 255u) == 0u) { if (xb_ld(&bar[XB_TMO])) break; if (sp > XB_SPIN_CAP) { atomicAdd(&bar[XB_TMO], 1u); break; } }
    }
    nloc = mine > 0u ? mine : 1u; nx = cnt > 0u ? cnt : 1u;
}

__device__ __forceinline__ void xcd_barrier(const XcdBarrier& b) {
    asm volatile("s_waitcnt vmcnt(0)" ::: "memory");
    __syncthreads();
    if (threadIdx.x == 0) {
        unsigned* bar = b.bar;
        __builtin_amdgcn_s_waitcnt(0);
        unsigned nloc = b.st[0], nx = b.st[1];
        if (nloc == 0u) { xcd_barrier_complete(bar, b.x, nloc, nx); b.st[0] = nloc; b.st[1] = nx; }
        const unsigned old = xb_add(&bar[XB_XSUB(b.x)], 1u);
        const unsigned gen = old / nloc;
        if (old + 1u == (gen + 1u) * nloc) {
            __builtin_amdgcn_fence(__ATOMIC_RELEASE, "agent");
            asm volatile("s_waitcnt vmcnt(0)" ::: "memory");
            const unsigned og = xb_add(&bar[XB_TOP], 1u);
            const unsigned tg = og / nx;
            if (og + 1u == (tg + 1u) * nx) xb_add(&bar[XB_TOPGEN], 1u);
            else XB_SPIN(xb_ld(&bar[XB_TOPGEN]) == tg, bar);
            __builtin_amdgcn_fence(__ATOMIC_ACQUIRE, "agent");
            xb_add(&bar[XB_XGEN(b.x)], 1u);
            asm volatile("s_waitcnt vmcnt(0)" ::: "memory");
        } else {
            XB_SPIN(xb_ld(&bar[XB_XGEN(b.x)]) == gen, bar);
            __builtin_amdgcn_fence(__ATOMIC_ACQUIRE, "agent");
            asm volatile("s_waitcnt vmcnt(0)" ::: "memory");
        }
    }
    __syncthreads();
}


struct Args { const float* in[N_IN]; float* out; unsigned char* ws; int ph_lo, ph_hi; };
static_assert(sizeof(Args) == (N_IN + 2) * 8 + 8, "Args has no padding");

constexpr int CV_ROWP = 144;
__device__ __forceinline__ void cv_tile(const float* W, int N, bf16* WT, int ldt, int dst_row0, LAS unsigned char* scr, int k0, int n0, int lane, const float* gain) {
    const int c4 = lane & 15, kq = lane >> 4;
#pragma unroll 4
    for (int i = 0; i < 16; ++i) { const int kk = 4 * i + kq; const f32x4 v = *(const GAS f32x4*)(W + (size_t)(k0 + kk) * N + n0 + 4 * c4); const float gk = gain ? gain[k0 + kk] : 1.0f;
        LAS unsigned char* p = scr + (4 * c4) * CV_ROWP + kk * 2;
        *(LAS unsigned short*)(p) = (unsigned short)f2bf(v.x * gk); *(LAS unsigned short*)(p + CV_ROWP) = (unsigned short)f2bf(v.y * gk);
        *(LAS unsigned short*)(p + 2 * CV_ROWP) = (unsigned short)f2bf(v.z * gk); *(LAS unsigned short*)(p + 3 * CV_ROWP) = (unsigned short)f2bf(v.w * gk); }
    LDS_WAIT(); asm volatile("" ::: "memory");
    const int c = lane & 7, nr = lane >> 3;
#pragma unroll
    for (int j = 0; j < 8; ++j) { const int n = nr + 8 * j; const v4u o = *(const LAS v4u*)(scr + n * CV_ROWP + c * 16);
        *(GAS v4u*)(WT + (size_t)(dst_row0 + n) * ldt + k0 + 8 * c) = o; }
    LDS_WAIT(); asm volatile("" ::: "memory");
}
constexpr int CV_FFN = 2816, CV_INA = 32 * 65, CV_INC = 32 * 128, CV_UQ = 8 * 24, CV_UKV = 8 * 32, CV_O = 32 * 32;
__device__ __forceinline__ void cv_ffn_item(const float* const* in, unsigned char* ws, int f, int l, int r, LAS unsigned char* scr, int lane) {
    const int type = r / CV_FFN, item = r % CV_FFN, inst = f * 4 + l;
    if (type < 2) { const float* src = in[f ? (type ? I_F2U : I_F2G) : (type ? I_F1U : I_F1G)] + (size_t)l * D * DFF; const int kb = item / 88, nb = item % 88, n0 = 64 * nb;
        cv_tile(src, DFF, (bf16*)(ws + WS_WGU) + (size_t)inst * 2 * DFF * D, D, 256 * (n0 >> 7) + (n0 & 127) + (type ? 128 : 0), scr, 64 * kb, n0, lane, in[f ? I_NF2 : I_NF1] + l * D); }
    else { const float* src = in[f ? I_F2D : I_F1D] + (size_t)l * DFF * D; const int kb = item >> 5, nb = item & 31;
        cv_tile(src, D, (bf16*)(ws + WS_WD) + (size_t)inst * D * DFF, DFF, 64 * nb, scr, 64 * kb, 64 * nb, lane, nullptr); }
}
__device__ __forceinline__ int cv_group_items(int g) { if (g == 0 || (g & 1) == 0) return 3 * CV_FFN; const int l = (g - 1) >> 1; return ((l & 1) ? CV_INC + CV_O : CV_INA + CV_UQ + CV_UKV + CV_O) + 3 * CV_FFN; }
__device__ __forceinline__ void cv_group_item(const float* const* in, unsigned char* ws, int g, int r, LAS unsigned char* scr, int lane) {
    if (g == 0) { cv_ffn_item(in, ws, 0, 0, r, scr, lane); return; }
    if ((g & 1) == 0) { cv_ffn_item(in, ws, 0, g >> 1, r, scr, lane); return; }
    const int l = (g - 1) >> 1, e = l >> 1;
    if (l & 1) {
        if (r < CV_INC) { const int kb = r >> 7, nb = r & 127; cv_tile(in[I_WINC] + (size_t)e * D * DINC, DINC, (bf16*)(ws + WS_WINC) + (size_t)e * DINC * D, D, 64 * nb, scr, 64 * kb, 64 * nb, lane, in[I_NMIX] + l * D); return; } r -= CV_INC;
        if (r < CV_O) { const int kb = r >> 5, nb = r & 31; cv_tile(in[I_WOC] + (size_t)e * D * D, D, (bf16*)(ws + WS_WOC) + (size_t)e * D * D, D, 64 * nb, scr, 64 * kb, 64 * nb, lane, nullptr); return; } r -= CV_O;
    } else {
        if (r < CV_INA) { const int kb = r / 65, nb = r % 65; cv_tile(in[I_WINA] + (size_t)e * D * DINA, DINA, (bf16*)(ws + WS_WINA) + (size_t)e * DINA_P * D, D, 64 * nb, scr, 64 * kb, 64 * nb, lane, in[I_NMIX] + l * D); return; } r -= CV_INA;
        if (r < CV_UQ) { const int kb = r / 24, nb = r % 24; cv_tile(in[I_WUQ] + (size_t)e * QL * 1536, 1536, (bf16*)(ws + WS_WUQ) + (size_t)e * 1536 * QL, QL, 64 * nb, scr, 64 * kb, 64 * nb, lane, nullptr); return; } r -= CV_UQ;
        if (r < CV_UKV) { const int kb = r >> 5, nb = r & 31, n0 = 64 * nb, hh = n0 >> 8, rr = n0 & 255;
            cv_tile(in[I_WUKV] + (size_t)e * KVL * 2048, 2048, (bf16*)(ws + WS_WUKV) + (size_t)e * 2048 * KVL, KVL, (rr < 128 ? 0 : 1024) + hh * 128 + (rr & 127), scr, 64 * kb, n0, lane, nullptr); return; } r -= CV_UKV;
        if (r < CV_O) { const int kb = r >> 5, nb = r & 31; cv_tile(in[I_WOA] + (size_t)e * D * D, D, (bf16*)(ws + WS_WOA) + (size_t)e * D * D, D, 64 * nb, scr, 64 * kb, 64 * nb, lane, nullptr); return; } r -= CV_O;
    }
    cv_ffn_item(in, ws, 1, l, r, scr, lane);
}
__device__ __forceinline__ void cv_group(const float* const* in, unsigned char* ws, int g, unsigned* ctr, LAS unsigned char* scr, int lane) {
    const int n = cv_group_items(g);
    for (;;) { unsigned base = 0; if (lane == 0) base = atomicAdd(ctr, 4u); base = (unsigned)__builtin_amdgcn_readfirstlane((int)base);
        if ((int)base >= n) break;
        for (int j = 0; j < 4; ++j) if ((int)base + j < n) cv_group_item(in, ws, g, (int)base + j, scr, lane); }
}
__device__ __forceinline__ void x_row_init(const float* xin, float* xrow, bf16* brow, pg8::ssq_t* ss, int lane) {
    const GAS f32x4* xr = (const GAS f32x4*)xin + lane; GAS f32x4* xo = (GAS f32x4*)xrow + lane; GAS v2u* o8 = (GAS v2u*)brow + lane;
    float s = 0.f;
#pragma unroll
    for (int j = 0; j < 8; ++j) { const f32x4 v = xr[64 * j]; s += (v.x * v.x + v.y * v.y) + (v.z * v.z + v.w * v.w); xo[64 * j] = v; v2u w; w.x = pk2(v.x, v.y); w.y = pk2(v.z, v.w); o8[64 * j] = w; }
    s = wave_sum(s);
    if (lane < 8) ss[lane] = lane == 0 ? s : 0.f;
}

namespace att {
constexpr int KROW = 400, VROW = 144;
constexpr int KBYTES = 64 * KROW, VBYTES = 128 * VROW, BUF = KBYTES + VBYTES;
constexpr int UNIT_OFF = 2 * BUF;
constexpr int NUNITS = DB * HEADS + NB * HEADS * 8;
constexpr float SC_LOG2E = 0.07216878364870322f * 1.44269504088896f;
static_assert(UNIT_OFF + 64 <= RING_BYTES, "attention LDS");

struct Stage { v4u kn[2]; v4u kp; v4u vt[2]; };

__device__ __forceinline__ void stage_load(Stage& s, const bf16* KN, const bf16* KP, const bf16* VTp, int kvrow, int h, int tid) {
#pragma unroll
    for (int i = 0; i < 2; ++i) { const int p = tid + 512 * i, key = p >> 4, c = p & 15; s.kn[i] = *(const GAS v4u*)(KN + (size_t)(kvrow + key) * 1024 + h * 128 + 8 * c); }
    { const int key = tid >> 3, c = tid & 7; s.kp = *(const GAS v4u*)(KP + (size_t)(kvrow + key) * 64 + 8 * c); }
#pragma unroll
    for (int i = 0; i < 2; ++i) { const int p = tid + 512 * i, dv = p >> 3, c = p & 7; s.vt[i] = *(const GAS v4u*)(VTp + (size_t)(h * 128 + dv) * KVROWS + kvrow + 8 * c); }
}
__device__ __forceinline__ void stage_store(const Stage& s, LAS unsigned char* buf, int tid) {
#pragma unroll
    for (int i = 0; i < 2; ++i) { const int p = tid + 512 * i, key = p >> 4, c = p & 15; *(LAS v4u*)(buf + key * KROW + c * 16) = s.kn[i]; }
    { const int key = tid >> 3, c = tid & 7; *(LAS v4u*)(buf + key * KROW + 256 + c * 16) = s.kp; }
#pragma unroll
    for (int i = 0; i < 2; ++i) { const int p = tid + 512 * i, dv = p >> 3, c = p & 7; *(LAS v4u*)(buf + KBYTES + dv * VROW + c * 16) = s.vt[i]; }
}

template <bool two>
__device__ __forceinline__ void attn_unit(int unit, LAS unsigned char* lds, const bf16* QB, const bf16* KN, const bf16* KP, const bf16* VTp, const float* rope, bf16* CAT, int tid, int wave, int lane) {
    const int fr = lane & 15, fq = lane >> 4;
    int h, qrow0, kvrow0, ntiles, wlimit, pos0; bool active;
    if constexpr (!two) { const int b = unit >> 3; h = unit & 7; qrow0 = MP + b * DSEQ; kvrow0 = MP + b * KVS; ntiles = KVS / 64; wlimit = ntiles; pos0 = PAST; active = wave < 4; }
    else { const int v = unit - DB * HEADS, qt = 7 - (v >> 7), bh = v & 127, b = bh >> 3; h = bh & 7; qrow0 = b * SEQ + 256 * qt; kvrow0 = b * SEQ; ntiles = 4 * qt + 4; wlimit = 4 * qt + (wave >> 1) + 1; pos0 = 256 * qt; active = true; }
    constexpr int rpw = two ? 32 : 16;
    bf16x8 q[2][6];
#pragma unroll
    for (int ks = 0; ks < 6; ++ks) q[1][ks] = (bf16x8){0, 0, 0, 0, 0, 0, 0, 0};
    if (active) {
#pragma unroll
        for (int rg = 0; rg < (two ? 2 : 1); ++rg) { const int rr = rpw * wave + 16 * rg + fr; const bf16* qp = QB + (size_t)(qrow0 + rr) * 1536 + h * QHD + 8 * fq;
#pragma unroll
            for (int ks = 0; ks < 6; ++ks) q[rg][ks] = *(const GAS bf16x8*)(qp + 32 * ks);
            const float* rp = rope + (size_t)(pos0 + rr) * 64 + 16 * fq;
#pragma unroll
            for (int j = 0; j < 8; ++j) { const float c = rp[2 * j], s = rp[2 * j + 1]; const float x1 = bf2f((unsigned short)q[rg][4][j]), x2 = bf2f((unsigned short)q[rg][5][j]);
                q[rg][4][j] = (short)f2bf(x1 * c - x2 * s); q[rg][5][j] = (short)f2bf(x1 * s + x2 * c); } }
    } else {
#pragma unroll
        for (int rg = 0; rg < 2; ++rg)
#pragma unroll
            for (int ks = 0; ks < 6; ++ks) q[rg][ks] = (bf16x8){0, 0, 0, 0, 0, 0, 0, 0};
    }
    f32x4 o[2][8]; float mrow[2], lrow[2];
#pragma unroll
    for (int rg = 0; rg < 2; ++rg) { mrow[rg] = -1e30f; lrow[rg] = 0.f;
#pragma unroll
        for (int n = 0; n < 8; ++n) o[rg][n] = (f32x4){0.f, 0.f, 0.f, 0.f}; }
    Stage st;
    stage_load(st, KN, KP, VTp, kvrow0, h, tid);
    stage_store(st, lds, tid);
    LDS_WAIT(); __syncthreads();
    for (int kt = 0; kt < ntiles; ++kt) {
        LAS unsigned char* cur = lds + (kt & 1) * BUF; LAS unsigned char* nxt = lds + ((kt + 1) & 1) * BUF;
        const bool more = kt + 1 < ntiles;
        if (more) stage_load(st, KN, KP, VTp, kvrow0 + 64 * (kt + 1), h, tid);
        if (active && kt < wlimit) {
            f32x4 s[2][4];
#pragma unroll
            for (int rg = 0; rg < 2; ++rg)
#pragma unroll
                for (int kk = 0; kk < 4; ++kk) s[rg][kk] = (f32x4){0.f, 0.f, 0.f, 0.f};
#pragma unroll
            for (int ks = 0; ks < 6; ++ks)
#pragma unroll
                for (int kk = 0; kk < 4; ++kk) { const bf16x8 kf = *(const LAS bf16x8*)(cur + (16 * kk + fr) * KROW + ks * 64 + fq * 16);
                    s[0][kk] = __builtin_amdgcn_mfma_f32_16x16x32_bf16(kf, q[0][ks], s[0][kk], 0, 0, 0);
                    if constexpr (two) s[1][kk] = __builtin_amdgcn_mfma_f32_16x16x32_bf16(kf, q[1][ks], s[1][kk], 0, 0, 0); }
            bf16x8 pb[2][2];
#pragma unroll
            for (int rg = 0; rg < (two ? 2 : 1); ++rg) {
                float mx = -1e30f;
#pragma unroll
                for (int kk = 0; kk < 4; ++kk) { s[rg][kk] = s[rg][kk] * SC_LOG2E; mx = fmaxf(mx, fmaxf(fmaxf(s[rg][kk][0], s[rg][kk][1]), fmaxf(s[rg][kk][2], s[rg][kk][3]))); }
                mx = fmaxf(mx, __shfl_xor(mx, 16)); mx = fmaxf(mx, __shfl_xor(mx, 32));
                const float mnew = fmaxf(mrow[rg], mx), alpha = __builtin_amdgcn_exp2f(mrow[rg] - mnew); mrow[rg] = mnew;
                float ps = 0.f;
#pragma unroll
                for (int kk = 0; kk < 4; ++kk)
#pragma unroll
                    for (int j = 0; j < 4; ++j) { const float p = __builtin_amdgcn_exp2f(s[rg][kk][j] - mnew); s[rg][kk][j] = p; ps += p; }
                lrow[rg] = lrow[rg] * alpha + ps;
#pragma unroll
                for (int n = 0; n < 8; ++n) o[rg][n] = o[rg][n] * alpha;
#pragma unroll
                for (int k2 = 0; k2 < 2; ++k2) { v4u w; w.x = pg8::cvt_pk_bf16(s[rg][2 * k2][0], s[rg][2 * k2][1]); w.y = pg8::cvt_pk_bf16(s[rg][2 * k2][2], s[rg][2 * k2][3]);
                    w.z = pg8::cvt_pk_bf16(s[rg][2 * k2 + 1][0], s[rg][2 * k2 + 1][1]); w.w = pg8::cvt_pk_bf16(s[rg][2 * k2 + 1][2], s[rg][2 * k2 + 1][3]); pb[rg][k2] = __builtin_bit_cast(bf16x8, w); }
            }
            if constexpr (!two) { pb[1][0] = (bf16x8){0, 0, 0, 0, 0, 0, 0, 0}; pb[1][1] = (bf16x8){0, 0, 0, 0, 0, 0, 0, 0}; }
            const LAS unsigned char* vb = cur + KBYTES;
#pragma unroll
            for (int n = 0; n < 8; ++n)
#pragma unroll
                for (int k2 = 0; k2 < 2; ++k2) { const LAS unsigned char* vp = vb + (16 * n + fr) * VROW + k2 * 64 + fq * 8;
                    const v2u lo = *(const LAS v2u*)vp, hi = *(const LAS v2u*)(vp + 32); const v4u w = {lo.x, lo.y, hi.x, hi.y}; const bf16x8 vf = __builtin_bit_cast(bf16x8, w);
                    o[0][n] = __builtin_amdgcn_mfma_f32_16x16x32_bf16(vf, pb[0][k2], o[0][n], 0, 0, 0);
                    if constexpr (two) o[1][n] = __builtin_amdgcn_mfma_f32_16x16x32_bf16(vf, pb[1][k2], o[1][n], 0, 0, 0); }
        }
        if (more) stage_store(st, nxt, tid);
        LDS_WAIT(); __syncthreads();
    }
    if (active) {
#pragma unroll
        for (int rg = 0; rg < (two ? 2 : 1); ++rg) { float l = lrow[rg]; l += __shfl_xor(l, 16); l += __shfl_xor(l, 32); const float inv = 1.0f / l;
            bf16* op = CAT + (size_t)(qrow0 + rpw * wave + 16 * rg + fr) * D + DCONV + h * VD + 4 * fq;
#pragma unroll
            for (int n = 0; n < 8; ++n) { v2u w; w.x = pg8::cvt_pk_bf16(o[rg][n][0] * inv, o[rg][n][1] * inv); w.y = pg8::cvt_pk_bf16(o[rg][n][2] * inv, o[rg][n][3] * inv); *(GAS v2u*)(op + 16 * n) = w; } }
    }
}
}

namespace gla {
#define WG_SYNC() do { asm volatile("s_waitcnt lgkmcnt(0)" ::: "memory"); __builtin_amdgcn_s_barrier(); asm volatile("" ::: "memory"); } while (0)
constexpr int ROWD = 272, ROWT = 144;
constexpr int KEND = 0, QT = KEND + 64 * ROWD, QJ = QT + 64 * ROWD, KLT = QJ + 160 * ROWD, VT = KLT + 128 * ROWT, SC = VT + 128 * ROWT, TOT = SC + 64 * ROWT, EAL = TOT + 2048, SSQ = EAL + 512, UNIT = SSQ + 2048, END = UNIT + 64;
static_assert(END <= RING_BYTES, "gla LDS");
constexpr int NUNITS = NB * HGH + DB * HGH;

__device__ __forceinline__ void load_raw(unsigned (&rq)[16], unsigned (&rg)[16], unsigned (&rv)[16], const bf16* zrow, int d) {
#pragma unroll
    for (int r = 0; r < 16; ++r) { const GAS bf16* p = (const GAS bf16*)(zrow + (size_t)r * DINC + d); rq[r] = p[0]; rg[r] = p[2048]; rv[r] = p[4096]; }
}

__device__ __forceinline__ void gla_unit(int unit, LAS unsigned char* lds, const bf16* ZC, const float* S0all  , const float* g_o, bf16* OB, float* hg_p  , float* hg_s  , int tid, int wave, int lane) {
    const int fr = lane & 15, fq = lane >> 4, d = tid & 127, sb = tid >> 7;
    const bool smp = unit >= NB * HGH;
    const int u2 = smp ? unit - NB * HGH : unit, b = u2 >> 4, h = u2 & 15;
    const int nch = smp ? 1 : SEQ / 64, row0 = smp ? MP + b * DSEQ : b * SEQ;
    float* sout = smp ? hg_s + ((size_t)(b * HGH + h) << 14) : hg_p + ((size_t)(b * HGH + h) << 14);
    f32x4 S[8];
    if (smp) { const float* s0 = S0all + ((size_t)(b * HGH + h) << 14) + 16 * wave + fr;
#pragma unroll
        for (int a = 0; a < 8; ++a)
#pragma unroll
            for (int e = 0; e < 4; ++e) S[a][e] = s0[(16 * a + 4 * fq + e) * 128]; }
    else {
#pragma unroll
        for (int a = 0; a < 8; ++a) S[a] = (f32x4){0.f, 0.f, 0.f, 0.f}; }
    float gov[4];
#pragma unroll
    for (int e = 0; e < 4; ++e) gov[e] = g_o[16 * wave + 4 * fq + e];
    unsigned rq[16], rg[16], rv[16];
    load_raw(rq, rg, rv, ZC + (size_t)(row0 + 16 * sb) * DINC + h * 128, d);
    LAS float* tot = (LAS float*)(lds + TOT); LAS float* eal = (LAS float*)(lds + EAL); LAS float* ssq = (LAS float*)(lds + SSQ);
    for (int c = 0; c < nch; ++c) {
        float fx[16], e1[16], bk[16];
        { float run = 0.f;
#pragma unroll
          for (int r = 0; r < 16; ++r) { const float g = bf2f(rg[r]); run += g; fx[r] = __builtin_amdgcn_exp2f(g * 1.44269504089f); }
          tot[sb * 128 + d] = run; }
        e1[0] = fx[0]; bk[15] = 1.0f;
#pragma unroll
        for (int r = 1; r < 16; ++r) { e1[r] = e1[r - 1] * fx[r]; bk[15 - r] = bk[16 - r] * fx[16 - r]; }
        WG_SYNC();
        float P[5]; P[0] = 0.f;
#pragma unroll
        for (int j = 0; j < 4; ++j) P[j + 1] = P[j] + tot[j * 128 + d];
        float Pi = 0.f, Pi1 = 0.f;
#pragma unroll
        for (int j = 0; j < 4; ++j) if (j == sb) { Pi = P[j]; Pi1 = P[j + 1]; }
        const float alast = P[4];
        const float e_tail = __expf(alast - Pi1);
        const float e_head = __expf(Pi);
        float Fj[3];
#pragma unroll
        for (int j = 0; j < 3; ++j) Fj[j] = __expf(Pi - P[j + 1]);
        if (sb == 0) eal[d] = __expf(alast);
        unsigned klt[8], vtt[8];
        LAS unsigned char* const kend_p = lds + KEND + (16 * sb) * ROWD + d * 2;
        LAS unsigned char* const qt_p = lds + QT + (16 * sb) * ROWD + d * 2;
#pragma unroll
        for (int r = 0; r < 16; r += 2) {
            float kl[2];
#pragma unroll
            for (int h2 = 0; h2 < 2; ++h2) { const int rr = r + h2;
                const float qv = bf2f(rq[rr]), kend = (1.0f - fx[rr]) * bk[rr], qe = qv * e1[rr];
                kl[h2] = kend * e_tail;
                const unsigned w = pg8::cvt_pk_bf16(kend, qe * e_head);
                *(LAS unsigned short*)(kend_p + rr * ROWD) = (unsigned short)w; *(LAS unsigned short*)(qt_p + rr * ROWD) = (unsigned short)(w >> 16);
                const float qd = qv * __builtin_amdgcn_rcpf(fmaxf(bk[rr], 1e-30f));
                if (sb == 0) { *(LAS unsigned short*)(lds + QJ + (0 + rr) * ROWD + d * 2) = (unsigned short)pg8::cvt_pk_bf16(qd, 0.f); }
                else if (sb == 1) { const unsigned u = pg8::cvt_pk_bf16(qe * Fj[0], qd);
                    *(LAS unsigned short*)(lds + QJ + (16 + rr) * ROWD + d * 2) = (unsigned short)u; *(LAS unsigned short*)(lds + QJ + (64 + rr) * ROWD + d * 2) = (unsigned short)(u >> 16); }
                else if (sb == 2) { const unsigned u = pg8::cvt_pk_bf16(qe * Fj[0], qe * Fj[1]), u2 = pg8::cvt_pk_bf16(qd, 0.f);
                    *(LAS unsigned short*)(lds + QJ + (32 + rr) * ROWD + d * 2) = (unsigned short)u; *(LAS unsigned short*)(lds + QJ + (64 + 16 + rr) * ROWD + d * 2) = (unsigned short)(u >> 16);
                    *(LAS unsigned short*)(lds + QJ + (112 + rr) * ROWD + d * 2) = (unsigned short)u2; }
                else { const unsigned u = pg8::cvt_pk_bf16(qe * Fj[0], qe * Fj[1]), u2 = pg8::cvt_pk_bf16(qe * Fj[2], qd);
                    *(LAS unsigned short*)(lds + QJ + (48 + rr) * ROWD + d * 2) = (unsigned short)u; *(LAS unsigned short*)(lds + QJ + (64 + 32 + rr) * ROWD + d * 2) = (unsigned short)(u >> 16);
                    *(LAS unsigned short*)(lds + QJ + (112 + 16 + rr) * ROWD + d * 2) = (unsigned short)u2; *(LAS unsigned short*)(lds + QJ + (144 + rr) * ROWD + d * 2) = (unsigned short)(u2 >> 16); }
            }
            klt[r >> 1] = pg8::cvt_pk_bf16(kl[0], kl[1]); vtt[r >> 1] = (unsigned)rv[r] | ((unsigned)rv[r + 1] << 16);
        }
        { LAS v4u* kp = (LAS v4u*)(lds + KLT + d * ROWT + sb * 32); kp[0] = (v4u){klt[0], klt[1], klt[2], klt[3]}; kp[1] = (v4u){klt[4], klt[5], klt[6], klt[7]};
          LAS v4u* vp = (LAS v4u*)(lds + VT + d * ROWT + sb * 32); vp[0] = (v4u){vtt[0], vtt[1], vtt[2], vtt[3]}; vp[1] = (v4u){vtt[4], vtt[5], vtt[6], vtt[7]}; }
        WG_SYNC();
        v2u gate[4];
#pragma unroll
        for (int tt = 0; tt < 4; ++tt) gate[tt] = *(const GAS v2u*)(ZC + (size_t)(row0 + 64 * c + 16 * tt + fr) * DINC + 6144 + h * 128 + 16 * wave + 4 * fq);
        asm volatile("" ::: "memory");
        { const int cn = c + 1 < nch ? c + 1 : c;
          load_raw(rq, rg, rv, ZC + (size_t)(row0 + 64 * cn + 16 * sb) * DINC + h * 128, d); }
#pragma unroll
        for (int rep = 0; rep < 2; ++rep) {
            const int task = wave + 8 * rep;
            if (task < 12) {
                int ti, tj; bool zero = false;
                switch (task) { case 0: ti = 0; tj = 0; break; case 1: ti = 1; tj = 0; break; case 2: ti = 1; tj = 1; break; case 3: ti = 2; tj = 0; break; case 4: ti = 2; tj = 1; break; case 5: ti = 2; tj = 2; break;
                                case 6: ti = 3; tj = 0; break; case 7: ti = 3; tj = 1; break; case 8: ti = 3; tj = 2; break; case 9: ti = 3; tj = 3; break; case 10: ti = 0; tj = 1; zero = true; break; default: ti = 2; tj = 3; zero = true; break; }
                f32x4 sacc = (f32x4){0.f, 0.f, 0.f, 0.f};
                if (!zero) {
                    const int rowb = (tj == 0 ? 0 : tj == 1 ? 64 : tj == 2 ? 112 : 144) + 16 * (ti - tj);
#pragma unroll
                    for (int ks = 0; ks < 4; ++ks) { const bf16x8 af = *(const LAS bf16x8*)(lds + KEND + (16 * tj + fr) * ROWD + ks * 64 + fq * 16);
                        const bf16x8 bfm = *(const LAS bf16x8*)(lds + QJ + (rowb + fr) * ROWD + ks * 64 + fq * 16);
                        sacc = __builtin_amdgcn_mfma_f32_16x16x32_bf16(af, bfm, sacc, 0, 0, 0); }
                    if (ti == tj) {
#pragma unroll
                        for (int e = 0; e < 4; ++e) if (4 * fq + e > fr) sacc[e] = 0.f; }
                }
                v2u w; w.x = pg8::cvt_pk_bf16(sacc[0], sacc[1]); w.y = pg8::cvt_pk_bf16(sacc[2], sacc[3]);
                *(LAS v2u*)(lds + SC + (16 * ti + fr) * ROWT + (16 * tj + 4 * fq) * 2) = w;
            }
        }
        f32x4 oacc[4];
#pragma unroll
        for (int tt = 0; tt < 4; ++tt) oacc[tt] = (f32x4){0.f, 0.f, 0.f, 0.f};
#pragma unroll
        for (int kp = 0; kp < 4; ++kp) {
            v4u w; w.x = pg8::cvt_pk_bf16(S[2 * kp][0], S[2 * kp][1]); w.y = pg8::cvt_pk_bf16(S[2 * kp][2], S[2 * kp][3]); w.z = pg8::cvt_pk_bf16(S[2 * kp + 1][0], S[2 * kp + 1][1]); w.w = pg8::cvt_pk_bf16(S[2 * kp + 1][2], S[2 * kp + 1][3]);
            const bf16x8 af = __builtin_bit_cast(bf16x8, w);
#pragma unroll
            for (int tt = 0; tt < 4; ++tt) { const LAS unsigned char* qp = lds + QT + (16 * tt + fr) * ROWD + (32 * kp + 4 * fq) * 2;
                const v2u lo = *(const LAS v2u*)qp, hi = *(const LAS v2u*)(qp + 32); const v4u qw = {lo.x, lo.y, hi.x, hi.y};
                oacc[tt] = __builtin_amdgcn_mfma_f32_16x16x32_bf16(af, __builtin_bit_cast(bf16x8, qw), oacc[tt], 0, 0, 0); }
        }
        bf16x8 vf[2];
#pragma unroll
        for (int ks = 0; ks < 2; ++ks) vf[ks] = *(const LAS bf16x8*)(lds + VT + (16 * wave + fr) * ROWT + ks * 64 + fq * 16);
#pragma unroll
        for (int a = 0; a < 8; ++a) { const f32x4 dec = *(const LAS f32x4*)(lds + EAL + (16 * a + 4 * fq) * 4); S[a] = S[a] * dec;
#pragma unroll
            for (int ks = 0; ks < 2; ++ks) { const bf16x8 af = *(const LAS bf16x8*)(lds + KLT + (16 * a + fr) * ROWT + ks * 64 + fq * 16);
                S[a] = __builtin_amdgcn_mfma_f32_16x16x32_bf16(af, vf[ks], S[a], 0, 0, 0); } }
        WG_SYNC();
#pragma unroll
        for (int tt = 0; tt < 4; ++tt) {
#pragma unroll
            for (int ks = 0; ks < 2; ++ks) if (ks == 0 || tt >= 2) { const bf16x8 bfm = *(const LAS bf16x8*)(lds + SC + (16 * tt + fr) * ROWT + ks * 64 + fq * 16);
                oacc[tt] = __builtin_amdgcn_mfma_f32_16x16x32_bf16(vf[ks], bfm, oacc[tt], 0, 0, 0); }
            float q2 = (oacc[tt][0] * oacc[tt][0] + oacc[tt][1] * oacc[tt][1]) + (oacc[tt][2] * oacc[tt][2] + oacc[tt][3] * oacc[tt][3]);
            q2 += __shfl_xor(q2, 16); q2 += __shfl_xor(q2, 32);
            if (fq == 0) ssq[wave * 64 + 16 * tt + fr] = q2;
        }
        WG_SYNC();
#pragma unroll
        for (int tt = 0; tt < 4; ++tt) { float q2 = 0.f;
#pragma unroll
            for (int w = 0; w < 8; ++w) q2 += ssq[w * 64 + 16 * tt + fr];
            const float rstd = __builtin_amdgcn_rsqf(q2 * (1.f / 128.f) + EPS);
            v2u w; w.x = pg8::cvt_pk_bf16(oacc[tt][0] * rstd * gov[0] * bflo(gate[tt].x), oacc[tt][1] * rstd * gov[1] * bfhi(gate[tt].x)); w.y = pg8::cvt_pk_bf16(oacc[tt][2] * rstd * gov[2] * bflo(gate[tt].y), oacc[tt][3] * rstd * gov[3] * bfhi(gate[tt].y));
            *(GAS v2u*)(OB + (size_t)(row0 + 64 * c + 16 * tt + fr) * D + h * 128 + 16 * wave + 4 * fq) = w; }
    }
#pragma unroll
    for (int a = 0; a < 8; ++a)
#pragma unroll
        for (int e = 0; e < 4; ++e) sout[(16 * a + 4 * fq + e) * 128 + 16 * wave + fr] = S[a][e];
    __syncthreads();
}
}

__device__ __forceinline__ void load8f(const bf16* p, float (&v)[8]) { const v4u w = *(const GAS v4u*)p; v[0] = bflo(w.x); v[1] = bfhi(w.x); v[2] = bflo(w.y); v[3] = bfhi(w.y); v[4] = bflo(w.z); v[5] = bfhi(w.z); v[6] = bflo(w.w); v[7] = bfhi(w.w); }
__device__ __forceinline__ void cu_row(const bf16* zrow, int c0, float (&cu)[8]) { float a[8], b[8]; load8f(zrow + 1024 + c0, a); load8f(zrow + 2048 + c0, b);
#pragma unroll
    for (int j = 0; j < 8; ++j) cu[j] = a[j] * b[j]; }
__device__ __forceinline__ void mixa_conv_strip(int m0, int e, const bf16* ZA, const float* cache_conv, const float* w_conv, bf16* CAT, float* out, int lane) {
    const bool smp = m0 >= MP; const int mm = smp ? m0 - MP : m0;
    const int b = smp ? mm >> 6 : mm >> 11, t0 = smp ? mm & 63 : mm & 2047, T = smp ? DSEQ : SEQ;
    const float* wc = w_conv + (size_t)e * 3 * DCONV;
#pragma unroll
    for (int half = 0; half < 2; ++half) {
        const int c0 = 512 * half + 8 * lane;
        float cu1[8], cu2[8], w0[8], w1[8], w2[8];
#pragma unroll
        for (int j = 0; j < 8; ++j) { w0[j] = wc[c0 + j]; w1[j] = wc[DCONV + c0 + j]; w2[j] = wc[2 * DCONV + c0 + j]; }
        if (t0 >= 2) { cu_row(ZA + (size_t)(m0 - 1) * DINA_P, c0, cu1); cu_row(ZA + (size_t)(m0 - 2) * DINA_P, c0, cu2); }
        else {
#pragma unroll
            for (int j = 0; j < 8; ++j) { cu1[j] = smp ? cache_conv[((size_t)(e * DB + b) * 2 + 1) * DCONV + c0 + j] : 0.f; cu2[j] = smp ? cache_conv[((size_t)(e * DB + b) * 2 + 0) * DCONV + c0 + j] : 0.f; } }
#pragma unroll
        for (int r = 0; r < 4; ++r) { const int m = m0 + r, t = t0 + r; const bf16* zrow = ZA + (size_t)m * DINA_P;
            float gb[8], cu0[8], y[8];
            load8f(zrow + c0, gb); cu_row(zrow, c0, cu0);
#pragma unroll
            for (int j = 0; j < 8; ++j) y[j] = gb[j] * (w0[j] * cu2[j] + w1[j] * cu1[j] + w2[j] * cu0[j]);
            v4u w; w.x = pk2(y[0], y[1]); w.y = pk2(y[2], y[3]); w.z = pk2(y[4], y[5]); w.w = pk2(y[6], y[7]);
            *(GAS v4u*)(CAT + (size_t)m * D + c0) = w;
            if (t >= T - 2) { float* cs = out + (smp ? O_CONVS + ((size_t)(e * DB + b) * 2 + (t - (T - 2))) * DCONV : O_CONVP + ((size_t)(e * NB + b) * 2 + (t - (T - 2))) * DCONV) + c0;
                *(GAS f32x4*)cs = (f32x4){cu0[0], cu0[1], cu0[2], cu0[3]}; *(GAS f32x4*)(cs + 4) = (f32x4){cu0[4], cu0[5], cu0[6], cu0[7]}; }
#pragma unroll
            for (int j = 0; j < 8; ++j) { cu2[j] = cu1[j]; cu1[j] = cu0[j]; }
        }
    }
}
__device__ __forceinline__ void mixa_row(int m, int e, const bf16* ZA, const float* g_q, const float* g_kv, const float* rope,
                                         bf16* CQN, bf16* KVIN, bf16* KPEB, float* out, int lane) {
    const bool smp = m >= MP; const int mm = smp ? m - MP : m;
    const int b = smp ? mm >> 6 : mm >> 11, t = smp ? mm & 63 : mm & 2047;
    const int kvrow = smp ? MP + b * KVS + PAST + t : m, pos = smp ? PAST + t : t;
    const bf16* zrow = ZA + (size_t)m * DINA_P;
    {
        float v[8]; load8f(zrow + 3072 + 8 * lane, v); float s = 0.f;
#pragma unroll
        for (int j = 0; j < 8; ++j) s += v[j] * v[j];
        const float rstd = 1.0f / sqrtf(wave_sum(s) * (1.f / QL) + EPS); const float* g = g_q + e * QL + 8 * lane;
        v4u w; w.x = pk2(v[0] * rstd * g[0], v[1] * rstd * g[1]); w.y = pk2(v[2] * rstd * g[2], v[3] * rstd * g[3]); w.z = pk2(v[4] * rstd * g[4], v[5] * rstd * g[5]); w.w = pk2(v[6] * rstd * g[6], v[7] * rstd * g[7]);
        *(GAS v4u*)(CQN + (size_t)m * QL + 8 * lane) = w;
    }
    {
        float v[8]; load8f(zrow + 3584 + 8 * lane, v); float s = 0.f;
#pragma unroll
        for (int j = 0; j < 8; ++j) s += v[j] * v[j];
        const float rstd = 1.0f / sqrtf(wave_sum(s) * (1.f / KVL) + EPS); const float* g = g_kv + e * KVL + 8 * lane;
#pragma unroll
        for (int j = 0; j < 8; ++j) v[j] = v[j] * rstd * g[j];
        v4u w; w.x = pk2(v[0], v[1]); w.y = pk2(v[2], v[3]); w.z = pk2(v[4], v[5]); w.w = pk2(v[6], v[7]);
        *(GAS v4u*)(KVIN + (size_t)kvrow * KVL + 8 * lane) = w;
        float* co = out + (smp ? O_CKVS + ((size_t)(e * DB + b) * DSEQ + t) * KVL : O_CKVP + ((size_t)(e * NB + b) * SEQ + t) * KVL) + 8 * lane;
        *(GAS f32x4*)co = (f32x4){v[0], v[1], v[2], v[3]}; *(GAS f32x4*)(co + 4) = (f32x4){v[4], v[5], v[6], v[7]};
    }
    if (lane < 32) {
        const float x1 = bf2f(zrow[4096 + lane]), x2 = bf2f(zrow[4096 + 32 + lane]);
        const float c = rope[(size_t)pos * 64 + 2 * lane], s = rope[(size_t)pos * 64 + 2 * lane + 1];
        const float r1 = x1 * c - x2 * s, r2 = x1 * s + x2 * c;
        float* ko = out + (smp ? O_KPES + ((size_t)(e * DB + b) * DSEQ + t) * ROPE : O_KPEP + ((size_t)(e * NB + b) * SEQ + t) * ROPE);
        ko[lane] = r1; ko[32 + lane] = r2;
        KPEB[(size_t)kvrow * ROPE + lane] = (bf16)f2bf(r1); KPEB[(size_t)kvrow * ROPE + 32 + lane] = (bf16)f2bf(r2);
    }
}

#ifndef REP_ATT
#define REP_ATT 1
#endif
#ifndef REP_GLA
#define REP_GLA 1
#endif
#ifndef REP_MIXA
#define REP_MIXA 1
#endif
#ifndef REP_NORM
#define REP_NORM 1
#endif
#ifndef REP_PRO
#define REP_PRO 1
#endif
#ifndef REP_GU
#define REP_GU 1
#endif
#ifndef MK_ONE_LAUNCH
#define MK_ONE_LAUNCH 1
#endif
constexpr int N_PHASES = 1 + 8 * 2 + 2 * 5 + 2 * 3 + 1;

#define PH_LOCALS \
    int tid = threadIdx.x; asm volatile("" : "+v"(tid)); const int lane = tid & 63, wave = __builtin_amdgcn_readfirstlane(tid >> 6); \
    GAS unsigned char* ws_ = (GAS unsigned char*)args.ws; asm volatile("" : "+s"(ws_)); unsigned char* ws = (unsigned char*)ws_;   \
    GAS float* X_ = (GAS float*)args.out; asm volatile("" : "+s"(X_)); float* X = (float*)X_; \
    int G = gridDim.x; asm volatile("" : "+s"(G)); int bid = blockIdx.x; asm volatile("" : "+s"(bid)); \
    const int gw = bid * NWAVES + wave, NGW = G * NWAVES; LAS unsigned char* lds = (LAS unsigned char*)lds_raw; \
    bf16* XN = (bf16*)(ws + WS_XN); bf16* CAT = (bf16*)(ws + WS_CAT); pg8::ssq_t* SSQ = (pg8::ssq_t*)(ws + WS_SS); (void)lane; (void)gw; (void)NGW; (void)XN; (void)CAT; (void)SSQ; (void)X; (void)lds;

__global__ void __launch_bounds__(NTHR, 2) mega_fwd(Args args) {
    extern __shared__ __attribute__((aligned(16))) unsigned char lds_raw[];
    XcdBarrier bar;
    {
        volatile LAS unsigned* MISC = (volatile LAS unsigned*)((LAS unsigned char*)lds_raw + MISC_OFF);
        if (threadIdx.x < 32) MISC[threadIdx.x] = 0u;
        __syncthreads();
        bar.bar = (unsigned*)(args.ws + WS_CTL) + CW_BAR; bar.x = 0; bar.st = nullptr;
        if (MK_ONE_LAUNCH) bar = xcd_barrier_post((unsigned*)(args.ws + WS_CTL) + CW_BAR, MISC + 8);
    }
    const int lo = args.ph_lo, hi = args.ph_hi;
    int ph = 0;
#define IN_PHASE (ph >= lo && ph < hi)
#define END_PHASE do { if (MK_ONE_LAUNCH && ph + 1 < hi && ph + 1 < N_PHASES) xcd_barrier(bar); ++ph; } while (0)

    if (IN_PHASE) {
        PH_LOCALS
        cv_group(args.in, ws, 0, (unsigned*)(ws + WS_CTL) + CW_CONV, lds + RING_OFF + wave * 16384, lane);
        const size_t gt = (size_t)bid * NTHR + tid, GT = (size_t)G * NTHR;
        for (size_t i = gt; i < (size_t)2 * (DINA_P - DINA) * D / 8; i += GT) { const size_t e = i / ((DINA_P - DINA) * D / 8), j = i % ((DINA_P - DINA) * D / 8);
            *(GAS v4u*)((bf16*)(ws + WS_WINA) + e * DINA_P * D + (size_t)DINA * D + j * 8) = (v4u){0u, 0u, 0u, 0u}; }
        for (int m = gw; m < M; m += NGW) x_row_init(m < MP ? args.in[I_XP] + (size_t)m * D : args.in[I_XS] + (size_t)(m - MP) * D, X + (size_t)m * D, XN + (size_t)m * D, SSQ + (size_t)m * 8, lane);
        for (size_t i = gt; i < (size_t)KVS * 32; i += GT) { const int pos = (int)(i >> 5), k = (int)(i & 31); const double inv = exp(-(double)k * (9.210340371976184 / 32.0)), ang = (double)pos * inv;
            float* rp = (float*)(ws + WS_ROPE) + 2 * i; rp[0] = (float)cos(ang); rp[1] = (float)sin(ang); }
        for (size_t i = gt; i < 2048; i += GT) { const float a = args.in[I_LB][i], b2 = args.in[I_LB][2048 + i]; float* lbp = (float*)(ws + WS_LB);
            lbp[i] = 0.f; lbp[2048 + i] = 1.0f / (1.0f + expf(a - b2)); }
    }
    END_PHASE;

#define FFN_STEP(F_) { \
        if (IN_PHASE) { PH_LOCALS const int inst = (F_) * 4 + l; pg8::Gemm g{XN, (const bf16*)(ws + WS_WGU) + (size_t)inst * 2 * DFF * D, M, 2 * DFF, D, D, D}; pg8::StaticOrder S; S.init(M, 2 * DFF, G, bid); \
            pg8::EpiSwiGLU E{(bf16*)(ws + WS_H), DFF, SSQ + (size_t)(3 * l + 2 * (F_)) * M * 8}; for (int rep_ = 0; rep_ < REP_GU; ++rep_) pg8::gemm_phase<pg8::EpiSwiGLU, pg8::StaticOrder, true, true>(lds + RING_OFF, g, S, E); } \
        END_PHASE; \
        if (IN_PHASE) { PH_LOCALS const int inst = (F_) * 4 + l; pg8::Gemm g{(const bf16*)(ws + WS_H), (const bf16*)(ws + WS_WD) + (size_t)inst * D * DFF, M, D, DFF, DFF, DFF}; pg8::StaticOrder S; S.init(M, D, G, bid); \
            const int site = 3 * l + 2 * (F_) + 1; const bool lastn = site >= 12; pg8::EpiResidNorm E{X, lastn ? nullptr : XN, lastn ? nullptr : SSQ + (size_t)site * M * 8, D, 0.5f, (PG8_LAS float*)(lds + EPI_P_OFF)}; pg8::gemm_phase<pg8::EpiResidNorm, pg8::StaticOrder, true, true>(lds + RING_OFF, g, S, E); \
            const int cg = 1 + 2 * l + (F_); if (cg < 8) cv_group(args.in, ws, cg, (unsigned*)(ws + WS_CTL) + CW_CONV + 64 * cg, lds + RING_OFF + wave * 16384, lane); } \
        END_PHASE; }

    for (int l = 0; l < DEPTH; ++l) {
        FFN_STEP(0)
        if ((l & 1) == 0) {
            const int e = l >> 1;
            if (IN_PHASE) { PH_LOCALS pg8::Gemm g{XN, (const bf16*)(ws + WS_WINA) + (size_t)e * DINA_P * D, M, DINA_P, D, D, D}; pg8::StaticOrder S; S.init(M, DINA_P, G, bid);
                pg8::EpiStore E{(bf16*)(ws + WS_ZA), DINA_P, SSQ + (size_t)(3 * l + 1) * M * 8}; pg8::gemm_phase<pg8::EpiStore, pg8::StaticOrder, true, true>(lds + RING_OFF, g, S, E); }
            END_PHASE;
            if (IN_PHASE) { PH_LOCALS
                bf16* ZA = (bf16*)(ws + WS_ZA); bf16* CQN = (bf16*)(ws + WS_CQN); bf16* KVIN = (bf16*)(ws + WS_KVIN); bf16* KPEB = (bf16*)(ws + WS_KPEB); const float* rope = (const float*)(ws + WS_ROPE);
                for (int rep = 0; rep < REP_MIXA; ++rep)
                for (int st = gw; st < M / 4; st += NGW) { mixa_conv_strip(4 * st, e, ZA, args.in[I_CCONV], args.in[I_WCONV], CAT, X, lane);
                    for (int r = 0; r < 4; ++r) mixa_row(4 * st + r, e, ZA, args.in[I_GQ], args.in[I_GKV], rope, CQN, KVIN, KPEB, X, lane); }
                for (int r = gw; r < DB * PAST; r += NGW) { const int b = r >> 12, s = r & 4095; const size_t kvrow = (size_t)MP + (size_t)b * KVS + s;
                    const float* src = args.in[I_CCKV] + ((size_t)(e * DB + b) * PAST + s) * KVL + 8 * lane; const f32x4 a = *(const GAS f32x4*)src, c = *(const GAS f32x4*)(src + 4);
                    v4u w; w.x = pk2(a.x, a.y); w.y = pk2(a.z, a.w); w.z = pk2(c.x, c.y); w.w = pk2(c.z, c.w); *(GAS v4u*)(KVIN + kvrow * KVL + 8 * lane) = w;
                    KPEB[kvrow * ROPE + lane] = (bf16)f2bf(args.in[I_CKPE][((size_t)(e * DB + b) * PAST + s) * ROPE + lane]); }
            }
            END_PHASE;
            if (IN_PHASE) { PH_LOCALS
                { pg8::Gemm g{(const bf16*)(ws + WS_CQN), (const bf16*)(ws + WS_WUQ) + (size_t)e * 1536 * QL, M, 1536, QL, QL, QL}; pg8::StaticOrder S; S.init(M, 1536, G, bid);
                  pg8::EpiStore E{(bf16*)(ws + WS_QB), 1536, nullptr}; pg8::gemm_phase<pg8::EpiStore, pg8::StaticOrder, true, true>(lds + RING_OFF, g, S, E); }
                { pg8::Gemm g{(const bf16*)(ws + WS_KVIN), (const bf16*)(ws + WS_WUKV) + (size_t)e * 2048 * KVL, KVROWS, 1024, KVL, KVL, KVL}; pg8::StaticOrder S; S.init(KVROWS, 1024, G, bid);
                  pg8::EpiStore E{(bf16*)(ws + WS_KNOPE), 1024, nullptr}; pg8::gemm_phase<pg8::EpiStore, pg8::StaticOrder, true, true>(lds + RING_OFF, g, S, E); }
                { pg8::Gemm g{(const bf16*)(ws + WS_WUKV) + (size_t)e * 2048 * KVL + (size_t)1024 * KVL, (const bf16*)(ws + WS_KVIN), 1024, KVROWS, KVL, KVL, KVL}; pg8::StaticOrder S; S.init(1024, KVROWS, G, bid);
                  pg8::EpiStore E{(bf16*)(ws + WS_VT), KVROWS, nullptr}; pg8::gemm_phase<pg8::EpiStore, pg8::StaticOrder, true, true>(lds + RING_OFF, g, S, E); }
            }
            END_PHASE;
            if (IN_PHASE) { PH_LOCALS
                for (int rep = 0; rep < REP_ATT; ++rep) {
                unsigned* ctr = (unsigned*)(ws + WS_CTL) + CW_ATTN + 64 * e + 1024 * rep;
                LAS unsigned* uw = (LAS unsigned*)(lds + att::UNIT_OFF);
                for (;;) {
                    if (tid == 0) *uw = atomicAdd(ctr, 1u);
                    LDS_WAIT(); __syncthreads();
                    const int unit = (int)*uw;
                    __syncthreads();
                    if (unit >= att::NUNITS) break;
                    if (unit < DB * HEADS) att::attn_unit<false>(unit, lds, (const bf16*)(ws + WS_QB), (const bf16*)(ws + WS_KNOPE), (const bf16*)(ws + WS_KPEB), (const bf16*)(ws + WS_VT), (const float*)(ws + WS_ROPE), CAT, tid, wave, lane);
                    else att::attn_unit<true>(unit, lds, (const bf16*)(ws + WS_QB), (const bf16*)(ws + WS_KNOPE), (const bf16*)(ws + WS_KPEB), (const bf16*)(ws + WS_VT), (const float*)(ws + WS_ROPE), CAT, tid, wave, lane);
                }
                }
            }
            END_PHASE;
            if (IN_PHASE) { PH_LOCALS pg8::Gemm g{CAT, (const bf16*)(ws + WS_WOA) + (size_t)e * D * D, M, D, D, D, D}; pg8::StaticOrder S; S.init(M, D, G, bid);
                pg8::EpiResidNorm E{X, XN, SSQ + (size_t)(3 * l + 2) * M * 8, D, 1.0f, (PG8_LAS float*)(lds + EPI_P_OFF)}; pg8::gemm_phase<pg8::EpiResidNorm, pg8::StaticOrder, true, true>(lds + RING_OFF, g, S, E); }
            END_PHASE;
        } else {
            const int o = l >> 1;
            if (IN_PHASE) { PH_LOCALS pg8::Gemm g{XN, (const bf16*)(ws + WS_WINC) + (size_t)o * DINC * D, M, DINC, D, D, D}; pg8::StaticOrder S; S.init(M, DINC, G, bid);
                pg8::EpiGla E{(bf16*)(ws + WS_ZC), DINC, (const float*)(ws + WS_LB) + o * 2048, SSQ + (size_t)(3 * l + 1) * M * 8}; pg8::gemm_phase<pg8::EpiGla, pg8::StaticOrder, true, true>(lds + RING_OFF, g, S, E); }
            END_PHASE;
            if (IN_PHASE) { PH_LOCALS
                for (int rep = 0; rep < REP_GLA; ++rep) {
                unsigned* ctr = (unsigned*)(ws + WS_CTL) + CW_GLA + 64 * o + 1024 * rep;
                LAS unsigned* uw = (LAS unsigned*)(lds + gla::UNIT);
                for (;;) {
                    if (tid == 0) *uw = atomicAdd(ctr, 1u);
                    LDS_WAIT(); __syncthreads();
                    const int unit = (int)*uw;
                    __syncthreads();
                    if (unit >= gla::NUNITS) break;
                    gla::gla_unit(unit, lds, (const bf16*)(ws + WS_ZC), args.in[I_SHG] + (size_t)o * DB * HGH * HGD * HGD, args.in[I_GO] + o * HGD, CAT,
                                  X + O_HGP + (size_t)o * NB * HGH * HGD * HGD, X + O_HGS + (size_t)o * DB * HGH * HGD * HGD, tid, wave, lane);
                }
                }
            }
            END_PHASE;
            if (IN_PHASE) { PH_LOCALS pg8::Gemm g{CAT, (const bf16*)(ws + WS_WOC) + (size_t)o * D * D, M, D, D, D, D}; pg8::StaticOrder S; S.init(M, D, G, bid);
                pg8::EpiResidNorm E{X, XN, SSQ + (size_t)(3 * l + 2) * M * 8, D, 1.0f, (PG8_LAS float*)(lds + EPI_P_OFF)}; pg8::gemm_phase<pg8::EpiResidNorm, pg8::StaticOrder, true, true>(lds + RING_OFF, g, S, E); }
            END_PHASE;
        }
        FFN_STEP(1)
    }
#undef FFN_STEP
    if (IN_PHASE) { PH_LOCALS
        const float* gain = args.in[I_NFIN];
        for (int m = gw; m < M; m += NGW) { GAS f32x4* xr = (GAS f32x4*)(X + (size_t)m * D) + lane; const GAS f32x4* gr = (const GAS f32x4*)gain + lane;
            f32x4 v[8]; float s = 0.f;
#pragma unroll
            for (int j = 0; j < 8; ++j) { v[j] = xr[64 * j]; s += (v[j].x * v[j].x + v[j].y * v[j].y) + (v[j].z * v[j].z + v[j].w * v[j].w); }
            const float rstd = 1.0f / sqrtf(wave_sum(s) * (1.f / D) + EPS);
#pragma unroll
            for (int j = 0; j < 8; ++j) xr[64 * j] = v[j] * rstd * gr[64 * j]; }
    }
    ++ph;
#undef IN_PHASE
#undef END_PHASE
}

extern "C" void kernel_launch(void* const* d_in, const int* in_sizes, int n_in, void* d_out, int out_size, void* d_ws, size_t ws_size, hipStream_t stream) {
    static int grid = 0;
    if (grid == 0) {
        if (n_in != N_IN || (size_t)out_size != O_END || ws_size < WS_TOTAL) { fprintf(stderr, "kernel_launch: unexpected shapes (n_in %d, out %d, ws %zu); nothing launched\n", n_in, out_size, ws_size); grid = -1; return; }
        int dev = 0, cus = 0, per_cu = 0;
        if (hipGetDevice(&dev) != hipSuccess || hipDeviceGetAttribute(&cus, hipDeviceAttributeMultiprocessorCount, dev) != hipSuccess) { grid = -1; return; }
        if (hipFuncSetAttribute((const void*)mega_fwd, hipFuncAttributeMaxDynamicSharedMemorySize, LDS_BYTES) != hipSuccess) { fprintf(stderr, "kernel_launch: hipFuncSetAttribute failed\n"); grid = -1; return; }
        if (hipOccupancyMaxActiveBlocksPerMultiprocessor(&per_cu, (const void*)mega_fwd, NTHR, LDS_BYTES) != hipSuccess || per_cu < 1) { fprintf(stderr, "kernel_launch: occupancy query says %d\n", per_cu); (void)hipGetLastError(); grid = -1; return; }
        grid = cus;
    }
    if (grid < 0) return;
    if (hipMemsetAsync((char*)d_ws + WS_CTL, 0, CTL_ZERO_BYTES, stream) != hipSuccess) return;
    Args a{};
    for (int i = 0; i < N_IN; ++i) a.in[i] = (const float*)d_in[i];
    a.out = (float*)d_out; a.ws = (unsigned char*)d_ws;
#if MK_ONE_LAUNCH
    a.ph_lo = 0; a.ph_hi = N_PHASES;
    hipLaunchKernelGGL(mega_fwd, dim3(grid), dim3(NTHR), LDS_BYTES, stream, a);
#else
    for (int p = 0; p < N_PHASES; ++p) { a.ph_lo = p; a.ph_hi = p + 1; hipLaunchKernelGGL(mega_fwd, dim3(grid), dim3(NTHR), LDS_BYTES, stream, a); }
#endif
}
```

```cpp
#include <hip/hip_runtime.h>
#include <cstdio>
#include <cstdint>
namespace pg8 {
#define PG8_LAS __attribute__((address_space(3)))
typedef unsigned short bf16_t;
typedef short bf16x8 __attribute__((ext_vector_type(8)));
typedef float f32x4 __attribute__((ext_vector_type(4)));
typedef unsigned u32x4 __attribute__((ext_vector_type(4)));
constexpr int BM = 256, BK = 64, HALF = 128, HTB = HALF * BK * 2  , STAGE_BYTES = 8 * HTB, NXCD = 8, WGM = 8;

__host__ __device__ __forceinline__ int lds_byte(int r, int c) { const int st = (r >> 4) * 2 + (c >> 5), rr = r & 15, cc = c & 31, ob = rr * 64 + cc * 2; return st * 1024 + (ob ^ (((ob >> 9) & 1) << 5)); }
__host__ __device__ __forceinline__ void stage_rc(int b, int& R, int& C) { const int st = b / 1024, sb = b % 1024, swz = sb ^ (((sb >> 9) & 1) << 5); R = (st >> 1) * 16 + swz / 64; C = (st & 1) * 32 + (swz % 64) / 2; }
__host__ __device__ __forceinline__ int perm32(int rho) { const int n = rho >> 4, i = rho & 15; return 8 * (i >> 2) + 4 * n + (i & 3); }

struct Unit { int pm, pn; };
struct Gemm { const bf16_t* A; const bf16_t* Bt; int M, N, K, lda, ldb; };

struct StaticOrder {
    int nM, nN, nwg, G, c, wgm;
    __host__ __device__ void init(int M, int N, int G_, int c_, int wgm_ = 4) { nM = M / BM; nN = N / BM; nwg = nM * nN; G = G_; c = c_; wgm = wgm_; }
    __host__ __device__ bool next(int i, Unit& u) const {
        const long L = (long)i * G + c; if (L >= nwg) return false;
        int wgid = (int)L; { const int q = nwg / NXCD, r = nwg % NXCD, xcd = wgid % NXCD, off = wgid / NXCD; wgid = (xcd < r ? xcd * (q + 1) : r * (q + 1) + (xcd - r) * q) + off; }
        const int nig = wgm * nN, gid = wgid / nig, fm = gid * wgm, gsz = (nM - fm) < wgm ? (nM - fm) : wgm;
        u.pm = fm + ((wgid % nig) % gsz); u.pn = (wgid % nig) / gsz; return true;
    }
    __device__ __forceinline__ void a_ready(const Unit&) const {}
    __device__ __forceinline__ void done(const Unit&) const {}
};

typedef float f32x2_t __attribute__((ext_vector_type(2))); typedef __bf16 bf16x2_t __attribute__((ext_vector_type(2)));
__device__ __forceinline__ unsigned cvt_pk_bf16(float lo, float hi) { const f32x2_t v = {lo, hi}; const bf16x2_t b = __builtin_convertvector(v, bf16x2_t); return __builtin_bit_cast(unsigned, b); }
typedef float f32x2 __attribute__((ext_vector_type(2)));
__device__ __forceinline__ float fast_sigmoid(float x) { return __builtin_amdgcn_rcpf(1.0f + __builtin_amdgcn_exp2f(-1.44269504089f * x)); }
__device__ __forceinline__ float fast_silu(float x) { return x * fast_sigmoid(x); }

typedef float ssq_t;
__device__ __forceinline__ float row_rstd(const ssq_t* ssp, int row) { const f32x4 a = *(const f32x4*)(ssp + (size_t)row * 8), b = *(const f32x4*)(ssp + (size_t)row * 8 + 4);
    return __builtin_amdgcn_rsqf((((a[0] + a[1]) + (a[2] + a[3])) + ((b[0] + b[1]) + (b[2] + b[3]))) * (1.0f / 2048.0f) + 1e-6f); }

struct RsRaw { f32x4 a, b; };
__device__ __forceinline__ RsRaw rs_issue(const ssq_t* ssp, const Unit& u, int wid, int lane) { RsRaw r; const ssq_t* p = ssp + (size_t)(u.pm * BM + wid * 32 + (lane & 31)) * 8; r.a = *(const f32x4*)p; r.b = *(const f32x4*)(p + 4); return r; }
__device__ __forceinline__ void rs_finish(const RsRaw& r, PG8_LAS float* rsbuf, int wid, int lane) { const f32x4 a = r.a, b = r.b;
    const float rs = __builtin_amdgcn_rsqf((((a[0] + a[1]) + (a[2] + a[3])) + ((b[0] + b[1]) + (b[2] + b[3]))) * (1.0f / 2048.0f) + 1e-6f); if (lane < 32) rsbuf[wid * 32 + lane] = rs; }
struct NoRaw {};

struct EpiStore {
    static constexpr bool PERM = true, AFTER_DRAIN = false; static constexpr int NSTORES = 16;
    bf16_t* O; int ldc; const ssq_t* ss;
    typedef RsRaw Raw;
    __device__ __forceinline__ Raw issue(const Unit& u, int wid, int lane) const { if (ss) return rs_issue(ss, u, wid, lane); return Raw{(f32x4){0.f, 0.f, 0.f, 0.f}, (f32x4){0.f, 0.f, 0.f, 0.f}}; }
    __device__ __forceinline__ void finish(const Raw& r, PG8_LAS float* rsbuf, int wid, int lane) const { if (ss) rs_finish(r, rsbuf, wid, lane); }
    __device__ __forceinline__ void operator()(const f32x4 (&acc)[2][2][4][2], const Unit& u, int wr, int wc, int fr, int fq, const PG8_LAS float* rsbuf) const {
        const int row0 = u.pm * BM + wr * 64 + fr, col0 = u.pn * BM + wc * 32 + 8 * fq;
#pragma unroll
        for (int ai = 0; ai < 2; ++ai)
#pragma unroll
            for (int m = 0; m < 4; ++m) { const int row = row0 + ai * HALF + m * 16; bf16_t* rowp = O + (size_t)row * ldc + col0; const float rs = ss ? rsbuf[ai * HALF + wr * 64 + m * 16 + fr] : 1.0f;
#pragma unroll
                for (int bj = 0; bj < 2; ++bj) { const f32x4 v0 = acc[ai][bj][m][0] * rs, v1 = acc[ai][bj][m][1] * rs;
                    u32x4 w; w.x = cvt_pk_bf16(v0[0], v0[1]); w.y = cvt_pk_bf16(v0[2], v0[3]); w.z = cvt_pk_bf16(v1[0], v1[1]); w.w = cvt_pk_bf16(v1[2], v1[3]);
                    *(u32x4*)(rowp + bj * HALF) = w; } }
    }
};
struct EpiSwiGLU {
    static constexpr bool PERM = true, AFTER_DRAIN = false; static constexpr int NSTORES = 8;
    bf16_t* O; int ldc; const ssq_t* ss;
    typedef RsRaw Raw;
    __device__ __forceinline__ Raw issue(const Unit& u, int wid, int lane) const { return rs_issue(ss, u, wid, lane); }
    __device__ __forceinline__ void finish(const Raw& r, PG8_LAS float* rsbuf, int wid, int lane) const { rs_finish(r, rsbuf, wid, lane); }
    __device__ __forceinline__ void operator()(const f32x4 (&acc)[2][2][4][2], const Unit& u, int wr, int wc, int fr, int fq, const PG8_LAS float* rsbuf) const {
        const int row0 = u.pm * BM + wr * 64 + fr, col0 = u.pn * HALF + wc * 32 + 8 * fq;
#pragma unroll
        for (int ai = 0; ai < 2; ++ai)
#pragma unroll
            for (int m = 0; m < 4; ++m) { const int row = row0 + ai * HALF + m * 16; bf16_t* rowp = O + (size_t)row * ldc + col0; const float rs = rsbuf[ai * HALF + wr * 64 + m * 16 + fr];
                f32x4 h0, h1;
#pragma unroll
                for (int j = 0; j < 4; ++j) { h0[j] = fast_silu(acc[ai][0][m][0][j] * rs) * (acc[ai][1][m][0][j] * rs); h1[j] = fast_silu(acc[ai][0][m][1][j] * rs) * (acc[ai][1][m][1][j] * rs); }
                u32x4 w; w.x = cvt_pk_bf16(h0[0], h0[1]); w.y = cvt_pk_bf16(h0[2], h0[3]); w.z = cvt_pk_bf16(h1[0], h1[1]); w.w = cvt_pk_bf16(h1[2], h1[3]);
                *(u32x4*)rowp = w; }
    }
};
struct EpiResidNorm {
    static constexpr bool PERM = true, AFTER_DRAIN = false; static constexpr int NSTORES = 16;
    bf16_t* XB; ssq_t* ss; int ldc; float scale; PG8_LAS float* P;
    typedef NoRaw Raw;
    __device__ __forceinline__ Raw issue(const Unit&, int, int) const { return Raw{}; }
    __device__ __forceinline__ void finish(const Raw&, PG8_LAS float*, int, int) const {}
    __device__ __forceinline__ void operator()(const f32x4 (&acc)[2][2][4][2], const Unit& u, int wr, int wc, int fr, int fq, const PG8_LAS float*) const {
        const int row0 = u.pm * BM + wr * 64 + fr, col0 = u.pn * BM + wc * 32 + 8 * fq;
#pragma unroll
        for (int ai = 0; ai < 2; ++ai) {
            u32x4 xv[4][2];
#pragma unroll
            for (int m = 0; m < 4; ++m) { const bf16_t* rowp = XB + (size_t)(row0 + ai * HALF + m * 16) * ldc + col0;
#pragma unroll
                for (int bj = 0; bj < 2; ++bj) xv[m][bj] = *(const u32x4*)(rowp + bj * HALF); }
#pragma unroll
            for (int m = 0; m < 4; ++m) { const int row = row0 + ai * HALF + m * 16; bf16_t* rowp = XB + (size_t)row * ldc + col0; float q = 0.f;
#pragma unroll
                for (int bj = 0; bj < 2; ++bj) { const u32x4 x = xv[m][bj];
                    const f32x4 x0 = {__builtin_bit_cast(float, x[0] << 16), __builtin_bit_cast(float, x[0] & 0xffff0000u), __builtin_bit_cast(float, x[1] << 16), __builtin_bit_cast(float, x[1] & 0xffff0000u)};
                    const f32x4 x1 = {__builtin_bit_cast(float, x[2] << 16), __builtin_bit_cast(float, x[2] & 0xffff0000u), __builtin_bit_cast(float, x[3] << 16), __builtin_bit_cast(float, x[3] & 0xffff0000u)};
                    const f32x4 v0 = x0 + acc[ai][bj][m][0] * scale, v1 = x1 + acc[ai][bj][m][1] * scale;
                    q += ((v0[0] * v0[0] + v0[1] * v0[1]) + (v0[2] * v0[2] + v0[3] * v0[3])) + ((v1[0] * v1[0] + v1[1] * v1[1]) + (v1[2] * v1[2] + v1[3] * v1[3]));
                    u32x4 w; w.x = cvt_pk_bf16(v0[0], v0[1]); w.y = cvt_pk_bf16(v0[2], v0[3]); w.z = cvt_pk_bf16(v1[0], v1[1]); w.w = cvt_pk_bf16(v1[2], v1[3]); *(u32x4*)(rowp + bj * HALF) = w; }
                q += __shfl_xor(q, 16); q += __shfl_xor(q, 32); if (fq == 0) P[(ai * HALF + wr * 64 + m * 16 + fr) * 4 + wc] = q; }
            asm volatile("" ::: "memory"); }
        {
            asm volatile("s_waitcnt lgkmcnt(0)" ::: "memory"); __builtin_amdgcn_s_barrier(); asm volatile("" ::: "memory");
            const int lane = fr + 16 * fq, r = (wr * 4 + wc) * 32 + lane;
            if (lane < 32) { const f32x4 p = *(const PG8_LAS f32x4*)(P + r * 4); ss[(size_t)(u.pm * BM + r) * 8 + u.pn] = (p[0] + p[1]) + (p[2] + p[3]); }
        }
    }
};
struct EpiGla {
    static constexpr bool PERM = true, AFTER_DRAIN = false; static constexpr int NSTORES = 16;
    bf16_t* O; int ldc; const float* lb; const ssq_t* ss;
    typedef RsRaw Raw;
    __device__ __forceinline__ Raw issue(const Unit& u, int wid, int lane) const { return rs_issue(ss, u, wid, lane); }
    __device__ __forceinline__ void finish(const Raw& r, PG8_LAS float* rsbuf, int wid, int lane) const { rs_finish(r, rsbuf, wid, lane); }
    __device__ __forceinline__ void operator()(const f32x4 (&acc)[2][2][4][2], const Unit& u, int wr, int wc, int fr, int fq, const PG8_LAS float* rsbuf) const {
        const int row0 = u.pm * BM + wr * 64 + fr, col0 = u.pn * BM + wc * 32 + 8 * fq;
        const int sec = u.pn >> 3;
        f32x4 lbv[2][2];
#pragma unroll
        for (int bj = 0; bj < 2; ++bj)
#pragma unroll
            for (int n = 0; n < 2; ++n) lbv[bj][n] = (sec == 1) ? *(const f32x4*)(lb + (col0 - 2048) + bj * HALF + 4 * n) : (f32x4){0.f, 0.f, 0.f, 0.f};
#pragma unroll
        for (int ai = 0; ai < 2; ++ai)
#pragma unroll
            for (int m = 0; m < 4; ++m) { const int row = row0 + ai * HALF + m * 16; bf16_t* rowp = O + (size_t)row * ldc + col0; const float rs = rsbuf[ai * HALF + wr * 64 + m * 16 + fr];
#pragma unroll
                for (int bj = 0; bj < 2; ++bj) { f32x4 v[2] = {acc[ai][bj][m][0] * rs, acc[ai][bj][m][1] * rs};
                    if (sec == 0 || sec == 3) {
#pragma unroll
                        for (int n = 0; n < 2; ++n)
#pragma unroll
                            for (int j = 0; j < 4; ++j) v[n][j] = fast_silu(v[n][j]);
                    } else if (sec == 1) {
#pragma unroll
                        for (int n = 0; n < 2; ++n)
#pragma unroll
                            for (int j = 0; j < 4; ++j) { const float l = lbv[bj][n][j]; v[n][j] = 0.69314718056f * __builtin_amdgcn_logf(l + (1.0f - l) * fast_sigmoid(v[n][j])); }
                    }
                    u32x4 w; w.x = cvt_pk_bf16(v[0][0], v[0][1]); w.y = cvt_pk_bf16(v[0][2], v[0][3]); w.z = cvt_pk_bf16(v[1][0], v[1][1]); w.w = cvt_pk_bf16(v[1][2], v[1][3]);
                    *(u32x4*)(rowp + bj * HALF) = w; } }
    }
};

template <class Epi, class Sched, bool ALIGN_EPI = false, bool SP2 = false>
__device__ __forceinline__ void gemm_phase(PG8_LAS unsigned char* lds, const Gemm g, const Sched& S, const Epi& E) {
    int tid_ = threadIdx.x; asm volatile("" : "+v"(tid_));
    const int tid = tid_, wid = __builtin_amdgcn_readfirstlane(tid >> 6), lane = tid & 63, wr = wid >> 2, wc = wid & 3, fr = lane & 15, fq = lane >> 4;
    const int K = g.K, nt = K / BK;
    unsigned voffA[2], voffB[2];
#pragma unroll
    for (int i = 0; i < 2; ++i) { int R, C; stage_rc(tid * 16 + i * 8192, R, C); const int Rb = Epi::PERM ? ((R & ~31) + perm32(R & 31)) : R;
        voffA[i] = (unsigned)(R * g.lda + C) * 2u; voffB[i] = (unsigned)(Rb * g.ldb + C) * 2u; }
    const size_t kstep = (size_t)(BK * 2);
    const size_t hstepA = (size_t)HALF * g.lda * 2, hstepB = (size_t)HALF * g.ldb * 2;
    const size_t tstepA = 2 * hstepA, tstepB = 2 * hstepB;
    const unsigned ldsw = (unsigned)wid * 1024u;
    const int aoff = lds_byte(wr * 64 + fr, fq * 8), boff = lds_byte(wc * 32 + fr, fq * 8);
#define PG8_SA(b, h) (((b) * 2 + (h)) * HTB)
#define PG8_SB(b, h) ((4 + (b) * 2 + (h)) * HTB)
#define PG8_STAGE(bufoff, gbase, voff) do { _Pragma("unroll") for (int _i = 0; _i < 2; ++_i) \
        __builtin_amdgcn_global_load_lds((const unsigned*)((const char*)(gbase) + (voff)[_i]), (PG8_LAS unsigned*)(lds + (bufoff) + ldsw + _i * 8192), 16, 0, 0); } while (0)
#define PG8_LDA(dst, b, h) do { _Pragma("unroll") for (int m = 0; m < 4; ++m) _Pragma("unroll") for (int k = 0; k < 2; ++k) dst[m][k] = *(const PG8_LAS bf16x8*)(lds + PG8_SA(b, h) + aoff + m * 2048 + k * 1024); } while (0)
#define PG8_LDB(dst, b, h) do { _Pragma("unroll") for (int n = 0; n < 2; ++n) _Pragma("unroll") for (int k = 0; k < 2; ++k) dst[n][k] = *(const PG8_LAS bf16x8*)(lds + PG8_SB(b, h) + boff + n * 2048 + k * 1024); } while (0)
#define PG8_MMA(ai, bj, At, Bt) do { __builtin_amdgcn_s_setprio(1); _Pragma("unroll") for (int m = 0; m < 4; ++m) _Pragma("unroll") for (int n = 0; n < 2; ++n) _Pragma("unroll") for (int k = 0; k < 2; ++k) \
        acc[ai][bj][m][n] = __builtin_amdgcn_mfma_f32_16x16x32_bf16(Bt[n][k], At[m][k], acc[ai][bj][m][n], 0, 0, 0); __builtin_amdgcn_s_setprio(0); } while (0)
#define PG8_WAIT_V(n) asm volatile("s_waitcnt vmcnt(" #n ")" ::: "memory")
#define PG8_WAIT_L(n) asm volatile("s_waitcnt lgkmcnt(" #n ")" ::: "memory")
#define PG8_BAR __builtin_amdgcn_s_barrier()
#define PG8_SCHED __builtin_amdgcn_sched_barrier(0)
    Unit cur, nxt; int ui = 0;
    if (!S.next(0, cur)) return;
    f32x4 acc[2][2][4][2];
#pragma unroll
    for (int a = 0; a < 2; ++a)
#pragma unroll
        for (int b = 0; b < 2; ++b)
#pragma unroll
            for (int m = 0; m < 4; ++m)
#pragma unroll
                for (int n = 0; n < 2; ++n) acc[a][b][m][n] = (f32x4){0.f, 0.f, 0.f, 0.f};
    bf16x8 At[4][2], B0[2][2], B1[2][2];
    const char* cA = (const char*)g.A + (size_t)cur.pm * tstepA; const char* cB = (const char*)g.Bt + (size_t)cur.pn * tstepB;
    S.a_ready(cur);
    PG8_LAS float* const rs_tab = (PG8_LAS float*)(lds + STAGE_BYTES + 256 + 4096);
    int rs_par = 0; E.finish(E.issue(cur, wid, lane), rs_tab, wid, lane);
    if constexpr (SP2) {
        PG8_STAGE(PG8_SB(0, 0), cB, voffB); PG8_STAGE(PG8_SB(0, 1), cB + hstepB, voffB); PG8_STAGE(PG8_SA(0, 0), cA, voffA); PG8_STAGE(PG8_SA(0, 1), cA + hstepA, voffA);
        if (wr == 1) PG8_BAR;
        PG8_WAIT_V(2); PG8_BAR;
        PG8_STAGE(PG8_SB(1, 0), cB + kstep, voffB); PG8_STAGE(PG8_SA(1, 0), cA + kstep, voffA); PG8_STAGE(PG8_SB(1, 1), cB + hstepB + kstep, voffB);
        PG8_WAIT_V(6); PG8_BAR;
    } else {
        PG8_STAGE(PG8_SB(0, 0), cB, voffB); PG8_STAGE(PG8_SA(0, 0), cA, voffA); PG8_STAGE(PG8_SB(0, 1), cB + hstepB, voffB); PG8_STAGE(PG8_SA(0, 1), cA + hstepA, voffA);
        if (wr == 1) PG8_BAR;
        PG8_WAIT_V(4); PG8_BAR;
        PG8_STAGE(PG8_SB(1, 0), cB + kstep, voffB); PG8_STAGE(PG8_SA(1, 0), cA + kstep, voffA); PG8_STAGE(PG8_SB(1, 1), cB + hstepB + kstep, voffB);
        PG8_WAIT_V(6); PG8_BAR;
    }
    for (;;) {
        const bool has_next = S.next(ui + 1, nxt);
        const char* nA = has_next ? (const char*)g.A + (size_t)nxt.pm * tstepA : cA; const char* nB = has_next ? (const char*)g.Bt + (size_t)nxt.pn * tstepB : cB;
        for (int t = 0; t < nt; t += 2) {
            const bool last = (t == nt - 2);
            const char* a1 = cA + (size_t)(t + 1) * kstep;
            const char* a2 = last ? nA : cA + (size_t)(t + 2) * kstep; const char* b2 = last ? nB : cB + (size_t)(t + 2) * kstep;
            const char* a3 = a2 + kstep; const char* b3 = b2 + kstep;
            if (last && has_next) S.a_ready(nxt);
            if constexpr (SP2) {
            PG8_LDB(B0, 0, 0); PG8_LDB(B1, 0, 1); PG8_SCHED; PG8_LDA(At, 0, 0); PG8_STAGE(PG8_SA(1, 1), a1 + hstepA, voffA);
            PG8_WAIT_V(8); PG8_WAIT_L(0); PG8_BAR; PG8_MMA(0, 0, At, B0); PG8_MMA(0, 1, At, B1); PG8_BAR; PG8_SCHED;
            PG8_LDA(At, 0, 1); PG8_STAGE(PG8_SB(0, 0), b2, voffB); PG8_STAGE(PG8_SB(0, 1), b2 + hstepB, voffB); PG8_STAGE(PG8_SA(0, 0), a2, voffA);
            PG8_WAIT_V(8); PG8_WAIT_L(0); PG8_BAR; PG8_MMA(1, 0, At, B0); PG8_MMA(1, 1, At, B1); PG8_BAR; PG8_SCHED;
            PG8_LDB(B0, 1, 0); PG8_LDB(B1, 1, 1); PG8_SCHED; PG8_LDA(At, 1, 0); PG8_STAGE(PG8_SA(0, 1), a2 + hstepA, voffA);
            PG8_WAIT_V(8); PG8_WAIT_L(0); PG8_BAR; PG8_MMA(0, 0, At, B0); PG8_MMA(0, 1, At, B1); PG8_BAR; PG8_SCHED;
            PG8_LDA(At, 1, 1); PG8_STAGE(PG8_SB(1, 0), b3, voffB); PG8_STAGE(PG8_SB(1, 1), b3 + hstepB, voffB); PG8_STAGE(PG8_SA(1, 0), a3, voffA);
            PG8_WAIT_V(8); PG8_WAIT_L(0); PG8_BAR; PG8_MMA(1, 0, At, B0); PG8_MMA(1, 1, At, B1); PG8_BAR; PG8_SCHED;
            } else {
            PG8_LDB(B0, 0, 0); PG8_SCHED; PG8_LDA(At, 0, 0); PG8_STAGE(PG8_SA(1, 1), a1 + hstepA, voffA);
            PG8_WAIT_L(8); PG8_BAR; PG8_WAIT_L(0); PG8_MMA(0, 0, At, B0); PG8_BAR; PG8_SCHED;
            PG8_LDB(B1, 0, 1); PG8_STAGE(PG8_SB(0, 0), b2, voffB);
            PG8_BAR; PG8_WAIT_L(0); PG8_MMA(0, 1, At, B1); PG8_BAR;
            PG8_LDA(At, 0, 1); PG8_STAGE(PG8_SA(0, 0), a2, voffA);
            PG8_BAR; PG8_WAIT_L(0); PG8_MMA(1, 0, At, B0); PG8_BAR; PG8_SCHED;
            PG8_STAGE(PG8_SB(0, 1), b2 + hstepB, voffB);
            PG8_WAIT_V(6); PG8_BAR; PG8_MMA(1, 1, At, B1); PG8_BAR;
            PG8_LDB(B0, 1, 0); PG8_SCHED; PG8_LDA(At, 1, 0); PG8_STAGE(PG8_SA(0, 1), a2 + hstepA, voffA);
            PG8_WAIT_L(8); PG8_BAR; PG8_WAIT_L(0); PG8_MMA(0, 0, At, B0); PG8_BAR; PG8_SCHED;
            PG8_LDB(B1, 1, 1); PG8_STAGE(PG8_SB(1, 0), b3, voffB);
            PG8_BAR; PG8_WAIT_L(0); PG8_MMA(0, 1, At, B1); PG8_BAR;
            PG8_LDA(At, 1, 1); PG8_STAGE(PG8_SA(1, 0), a3, voffA);
            PG8_BAR; PG8_WAIT_L(0); PG8_MMA(1, 0, At, B0); PG8_BAR; PG8_SCHED;
            PG8_STAGE(PG8_SB(1, 1), b3 + hstepB, voffB);
            PG8_WAIT_V(6); PG8_BAR; PG8_MMA(1, 1, At, B1); PG8_BAR;
            }
        }
        if constexpr (ALIGN_EPI) { if (wr == 0) PG8_BAR; }
        if constexpr (!Epi::AFTER_DRAIN) { typename Epi::Raw raw = E.issue(has_next ? nxt : cur, wid, lane); E(acc, cur, wr, wc, fr, fq, rs_tab + rs_par * 256); rs_par ^= 1; E.finish(raw, rs_tab + rs_par * 256, wid, lane); S.done(cur); }
        if (!has_next) break;
#pragma unroll
        for (int a = 0; a < 2; ++a)
#pragma unroll
            for (int b = 0; b < 2; ++b)
#pragma unroll
                for (int m = 0; m < 4; ++m)
#pragma unroll
                    for (int n = 0; n < 2; ++n) acc[a][b][m][n] = (f32x4){0.f, 0.f, 0.f, 0.f};
        cur = nxt; cA = nA; cB = nB; ++ui;
        if constexpr (ALIGN_EPI) { if (wr == 1) PG8_BAR; }
    }
    PG8_WAIT_V(0);
    if constexpr (!ALIGN_EPI) { if (wr == 0) PG8_BAR; }
    PG8_BAR;
#undef PG8_SA
#undef PG8_SB
#undef PG8_STAGE
#undef PG8_LDA
#undef PG8_LDB
#undef PG8_MMA
#undef PG8_WAIT_V
#undef PG8_WAIT_L
#undef PG8_BAR
#undef PG8_SCHED
}
}
constexpr int D = 2048, DFF = 5632, NB = 16, SEQ = 2048, DB = 8, DSEQ = 64, PAST = 4096, DEPTH = 4;
constexpr int MP = NB * SEQ, MS = DB * DSEQ, M = MP + MS;
constexpr int KVS = PAST + DSEQ;
constexpr int KVROWS = MP + DB * KVS;
constexpr int DCONV = 1024, QL = 512, KVL = 512, ROPE = 64, NOPE = 128, VD = 128, HEADS = 8, QHD = NOPE + ROPE;
constexpr int DINA = 3 * DCONV + QL + KVL + ROPE, DINA_P = 4352, DINC = 8192, HGH = 16, HGD = 128;
constexpr float EPS = 1e-6f;
static_assert(M % 256 == 0 && KVROWS % 256 == 0 && DINA == 4160, "shapes");
constexpr size_t O_YP = 0, O_YS = O_YP + (size_t)MP * D, O_CONVP = O_YS + (size_t)MS * D, O_CKVP = O_CONVP + (size_t)2 * NB * 2 * DCONV, O_KPEP = O_CKVP + (size_t)2 * NB * SEQ * KVL,
                 O_HGP = O_KPEP + (size_t)2 * NB * SEQ * ROPE, O_CONVS = O_HGP + (size_t)2 * NB * HGH * HGD * HGD, O_CKVS = O_CONVS + (size_t)2 * DB * 2 * DCONV,
                 O_KPES = O_CKVS + (size_t)2 * DB * DSEQ * KVL, O_HGS = O_KPES + (size_t)2 * DB * DSEQ * ROPE, O_END = O_HGS + (size_t)2 * DB * HGH * HGD * HGD;
static_assert(O_END == 119177216, "output size");
enum { I_XP = 0, I_XS, I_CCONV, I_CCKV, I_CKPE, I_SHG, I_NF1, I_F1G, I_F1U, I_F1D, I_NMIX, I_WINA, I_WCONV, I_GQ, I_WUQ, I_GKV, I_WUKV, I_WOA, I_WINC, I_LB, I_GO, I_WOC, I_NF2, I_F2G, I_F2U, I_F2D, I_NFIN, N_IN };

constexpr size_t MiB = 1u << 20;
constexpr size_t WS_CTL = 0, CTL_ZERO_BYTES = 1 * MiB;
constexpr size_t WS_ROPE = 4 * MiB;
constexpr size_t WS_LB = 5 * MiB + 512 * 1024;
constexpr size_t WS_WGU = 6 * MiB;
constexpr size_t WS_WD = WS_WGU + 8 * 44 * MiB;
constexpr size_t WS_WINA = WS_WD + 8 * 22 * MiB;
constexpr size_t WS_WINC = WS_WINA + 2 * 17 * MiB;
constexpr size_t WS_WUQ = WS_WINC + 2 * 32 * MiB;
constexpr size_t WS_WUKV = WS_WUQ + 3 * MiB;
constexpr size_t WS_WOA = WS_WUKV + 4 * MiB;
constexpr size_t WS_WOC = WS_WOA + 16 * MiB;
constexpr size_t WS_XN = WS_WOC + 16 * MiB;
constexpr size_t WS_CAT = WS_XN + 130 * MiB;
constexpr size_t WS_BIG = WS_CAT + 130 * MiB;
constexpr size_t WS_H = WS_BIG;
constexpr size_t WS_ZC = WS_BIG;
constexpr size_t WS_CQN = WS_BIG;
constexpr size_t WS_KVIN = WS_BIG + 33 * MiB;
constexpr size_t WS_KPEB = WS_BIG + 98 * MiB;
constexpr size_t WS_ZA = WS_BIG + 107 * MiB;
constexpr size_t WS_QB = WS_BIG + 107 * MiB;
constexpr size_t WS_KNOPE = WS_BIG + 205 * MiB;
constexpr size_t WS_VT = WS_BIG + 384 * MiB;
constexpr size_t WS_END = WS_BIG + 520 * MiB;
constexpr size_t WS_SS = WS_END;
constexpr size_t WS_SS_BYTES = (size_t)13 * M * 8 * 4, WS_TOTAL = WS_END + 14 * MiB;
static_assert(WS_END + WS_SS_BYTES <= WS_TOTAL, "ss map");
static_assert(WS_ZA + (size_t)M * DINA_P * 2 <= WS_VT && WS_KNOPE + (size_t)KVROWS * 1024 * 2 <= WS_VT && WS_QB + (size_t)M * 1536 * 2 <= WS_KNOPE && WS_VT + (size_t)1024 * KVROWS * 2 <= WS_END, "even-layer map");
static_assert(WS_CQN + (size_t)M * 512 * 2 <= WS_KVIN && WS_KVIN + (size_t)KVROWS * 512 * 2 <= WS_KPEB && WS_KPEB + (size_t)KVROWS * 64 * 2 <= WS_ZA, "even-layer map 2");
static_assert(WS_ZC + (size_t)M * DINC * 2 <= WS_END && WS_H + (size_t)M * DFF * 2 <= WS_END, "odd/ffn map");
static_assert(WS_ROPE + (size_t)KVS * 64 * 4 <= WS_LB && WS_LB + 2 * 2048 * 4 <= WS_WGU, "ctl map");
constexpr int CW_BAR = 4096;
constexpr int CW_ATTN = 8192;
constexpr int CW_GLA = 8192 + 256;
constexpr int CW_CONV = 8192 + 512;

constexpr int RING_OFF = 0, RING_BYTES = 131072;
constexpr int MISC_OFF = RING_BYTES;
constexpr int EPI_P_OFF = RING_BYTES + 256;
constexpr int LDS_BYTES = 147456;
constexpr int NWAVES = 8, NTHR = 512;

#define GAS __attribute__((address_space(1)))
#define CAS __attribute__((address_space(4)))
#define LAS __attribute__((address_space(3)))
typedef unsigned short bf16;
typedef unsigned v4u __attribute__((ext_vector_type(4)));
typedef unsigned v2u __attribute__((ext_vector_type(2)));
typedef float f32x4 __attribute__((ext_vector_type(4)));
typedef short bf16x8 __attribute__((ext_vector_type(8)));
#define LDS_WAIT() asm volatile("s_waitcnt lgkmcnt(0)" ::: "memory")
#define VM_WAIT() asm volatile("s_waitcnt vmcnt(0)" ::: "memory")
__device__ __forceinline__ unsigned f2bf(float f) { unsigned u = __builtin_bit_cast(unsigned, f); return (u + 0x7fffu + ((u >> 16) & 1u)) >> 16; }
__device__ __forceinline__ unsigned pk2(float lo, float hi) { return f2bf(lo) | (f2bf(hi) << 16); }
__device__ __forceinline__ float bf2f(unsigned b) { return __builtin_bit_cast(float, b << 16); }
__device__ __forceinline__ float bflo(unsigned w) { return __builtin_bit_cast(float, w << 16); }
__device__ __forceinline__ float bfhi(unsigned w) { return __builtin_bit_cast(float, w & 0xffff0000u); }
__device__ __forceinline__ float wave_sum(float v) {
#pragma unroll
    for (int o = 1; o < 64; o <<= 1) v += __shfl_xor(v, o);
    return v;
}
#define XB_TMO      128
#define XB_XCNT(j)  (256  + 64 * (j))
#define XB_XSUB(j)  (1280 + 64 * (j))
#define XB_XGEN(j)  (2304 + 64 * (j))
#define XB_TOP      3328
#define XB_TOPGEN   3392
#define XCD_BAR_WORDS 3456
#define XB_SPIN_CAP (1u << 18)

__device__ __forceinline__ unsigned xb_ld(unsigned* p)              { return __hip_atomic_load(p, __ATOMIC_RELAXED, __HIP_MEMORY_SCOPE_AGENT); }
__device__ __forceinline__ unsigned xb_add(unsigned* p, unsigned v) { return __hip_atomic_fetch_add(p, v, __ATOMIC_RELAXED, __HIP_MEMORY_SCOPE_AGENT); }
__device__ __forceinline__ unsigned xb_xcc_id() { return (unsigned)__builtin_amdgcn_s_getreg((3 << 11) | 20) & 0xFu; }
#define XB_SPIN(cond, bar) do { unsigned _sp = 0; while (cond) { __builtin_amdgcn_s_sleep(1); \
    if ((++_sp & 255u) == 0u) { if (xb_ld(&(bar)[XB_TMO])) break; if (_sp > XB_SPIN_CAP) { atomicAdd(&(bar)[XB_TMO], 1u); break; } } } } while (0)

struct XcdBarrier {
    unsigned* bar; unsigned x;
    volatile LAS unsigned* st;
};

__device__ __forceinline__ XcdBarrier xcd_barrier_post(unsigned* bar, volatile LAS unsigned* st) {
    XcdBarrier b; b.bar = bar; b.x = xb_xcc_id(); b.st = st;
    if (threadIdx.x == 0) (void)xb_add(&bar[XB_XCNT(b.x)], 1u);
    return b;
}
__device__ __forceinline__ void xcd_barrier_complete(unsigned* bar, unsigned x, unsigned& nloc, unsigned& nx) {
    const unsigned G = gridDim.x * gridDim.y * gridDim.z;
    unsigned sum, cnt, mine, sp = 0u;
    for (;;) {
        sum = 0u; cnt = 0u; mine = 0u;
#pragma unroll
        for (unsigned j = 0; j < 16; ++j) { const unsigned c = xb_ld(&bar[XB_XCNT(j)]); sum += c; cnt += (c > 0u) ? 1u : 0u; mine = (j == x) ? c : mine; }
        if (sum == G) break;
        __builtin_amdgcn_s_sleep(1);
        if ((++sp & 255u) == 0u) { if (xb_ld(&bar[XB_TMO])) break; if (sp > XB_SPIN_CAP) { atomicAdd(&bar[XB_TMO], 1u); break; } }
    }
    nloc = mine > 0u ? mine : 1u; nx = cnt > 0u ? cnt : 1u;
}

__device__ __forceinline__ void xcd_barrier(const XcdBarrier& b) {
    asm volatile("s_waitcnt vmcnt(0)" ::: "memory");
    __syncthreads();
    if (threadIdx.x == 0) {
        unsigned* bar = b.bar;
        __builtin_amdgcn_s_waitcnt(0);
        unsigned nloc = b.st[0], nx = b.st[1];
        if (nloc == 0u) { xcd_barrier_complete(bar, b.x, nloc, nx); b.st[0] = nloc; b.st[1] = nx; }
        const unsigned old = xb_add(&bar[XB_XSUB(b.x)], 1u);
        const unsigned gen = old / nloc;
        if (old + 1u == (gen + 1u) * nloc) {
            __builtin_amdgcn_fence(__ATOMIC_RELEASE, "agent");
            asm volatile("s_waitcnt vmcnt(0)" ::: "memory");
            const unsigned og = xb_add(&bar[XB_TOP], 1u);
            const unsigned tg = og / nx;
            if (og + 1u == (tg + 1u) * nx) xb_add(&bar[XB_TOPGEN], 1u);
            else XB_SPIN(xb_ld(&bar[XB_TOPGEN]) == tg, bar);
            __builtin_amdgcn_fence(__ATOMIC_ACQUIRE, "agent");
            xb_add(&bar[XB_XGEN(b.x)], 1u);
            asm volatile("s_waitcnt vmcnt(0)" ::: "memory");
        } else {
            XB_SPIN(xb_ld(&bar[XB_XGEN(b.x)]) == gen, bar);
            __builtin_amdgcn_fence(__ATOMIC_ACQUIRE, "agent");
            asm volatile("s_waitcnt vmcnt(0)" ::: "memory");
        }
    }
    __syncthreads();
}


struct Args { const float* in[N_IN]; float* out; unsigned char* ws; int ph_lo, ph_hi; };
static_assert(sizeof(Args) == (N_IN + 2) * 8 + 8, "Args has no padding");

constexpr int CV_ROWP = 144;
__device__ __forceinline__ void cv_tile(const float* W, int N, bf16* WT, int ldt, int dst_row0, LAS unsigned char* scr, int k0, int n0, int lane, const float* gain) {
    const int c4 = lane & 15, kq = lane >> 4;
#pragma unroll 4
    for (int i = 0; i < 16; ++i) { const int kk = 4 * i + kq; const f32x4 v = *(const GAS f32x4*)(W + (size_t)(k0 + kk) * N + n0 + 4 * c4); const float gk = gain ? gain[k0 + kk] : 1.0f;
        LAS unsigned char* p = scr + (4 * c4) * CV_ROWP + kk * 2;
        *(LAS unsigned short*)(p) = (unsigned short)f2bf(v.x * gk); *(LAS unsigned short*)(p + CV_ROWP) = (unsigned short)f2bf(v.y * gk);
        *(LAS unsigned short*)(p + 2 * CV_ROWP) = (unsigned short)f2bf(v.z * gk); *(LAS unsigned short*)(p + 3 * CV_ROWP) = (unsigned short)f2bf(v.w * gk); }
    LDS_WAIT(); asm volatile("" ::: "memory");
    const int c = lane & 7, nr = lane >> 3;
#pragma unroll
    for (int j = 0; j < 8; ++j) { const int n = nr + 8 * j; const v4u o = *(const LAS v4u*)(scr + n * CV_ROWP + c * 16);
        *(GAS v4u*)(WT + (size_t)(dst_row0 + n) * ldt + k0 + 8 * c) = o; }
    LDS_WAIT(); asm volatile("" ::: "memory");
}
constexpr int CV_FFN = 2816, CV_INA = 32 * 65, CV_INC = 32 * 128, CV_UQ = 8 * 24, CV_UKV = 8 * 32, CV_O = 32 * 32;
__device__ __forceinline__ void cv_ffn_item(const float* const CAS* in, unsigned char* ws, int f, int l, int r, LAS unsigned char* scr, int lane) {
    const int type = r / CV_FFN, item = r % CV_FFN, inst = f * 4 + l;
    if (type < 2) { const float* src = in[f ? (type ? I_F2U : I_F2G) : (type ? I_F1U : I_F1G)] + (size_t)l * D * DFF; const int kb = item / 88, nb = item % 88, n0 = 64 * nb;
        cv_tile(src, DFF, (bf16*)(ws + WS_WGU) + (size_t)inst * 2 * DFF * D, D, 256 * (n0 >> 7) + (n0 & 127) + (type ? 128 : 0), scr, 64 * kb, n0, lane, in[f ? I_NF2 : I_NF1] + l * D); }
    else { const float* src = in[f ? I_F2D : I_F1D] + (size_t)l * DFF * D; const int kb = item >> 5, nb = item & 31;
        cv_tile(src, D, (bf16*)(ws + WS_WD) + (size_t)inst * D * DFF, DFF, 64 * nb, scr, 64 * kb, 64 * nb, lane, nullptr); }
}
__device__ __forceinline__ int cv_group_items(int g) { if (g == 0 || (g & 1) == 0) return 3 * CV_FFN; const int l = (g - 1) >> 1; return ((l & 1) ? CV_INC + CV_O : CV_INA + CV_UQ + CV_UKV + CV_O) + 3 * CV_FFN; }
__device__ __forceinline__ void cv_group_item(const float* const CAS* in, unsigned char* ws, int g, int r, LAS unsigned char* scr, int lane) {
    if (g == 0) { cv_ffn_item(in, ws, 0, 0, r, scr, lane); return; }
    if ((g & 1) == 0) { cv_ffn_item(in, ws, 0, g >> 1, r, scr, lane); return; }
    const int l = (g - 1) >> 1, e = l >> 1;
    if (l & 1) {
        if (r < CV_INC) { const int kb = r >> 7, nb = r & 127; cv_tile(in[I_WINC] + (size_t)e * D * DINC, DINC, (bf16*)(ws + WS_WINC) + (size_t)e * DINC * D, D, 64 * nb, scr, 64 * kb, 64 * nb, lane, in[I_NMIX] + l * D); return; } r -= CV_INC;
        if (r < CV_O) { const int kb = r >> 5, nb = r & 31; cv_tile(in[I_WOC] + (size_t)e * D * D, D, (bf16*)(ws + WS_WOC) + (size_t)e * D * D, D, 64 * nb, scr, 64 * kb, 64 * nb, lane, nullptr); return; } r -= CV_O;
    } else {
        if (r < CV_INA) { const int kb = r / 65, nb = r % 65; cv_tile(in[I_WINA] + (size_t)e * D * DINA, DINA, (bf16*)(ws + WS_WINA) + (size_t)e * DINA_P * D, D, 64 * nb, scr, 64 * kb, 64 * nb, lane, in[I_NMIX] + l * D); return; } r -= CV_INA;
        if (r < CV_UQ) { const int kb = r / 24, nb = r % 24; cv_tile(in[I_WUQ] + (size_t)e * QL * 1536, 1536, (bf16*)(ws + WS_WUQ) + (size_t)e * 1536 * QL, QL, 64 * nb, scr, 64 * kb, 64 * nb, lane, nullptr); return; } r -= CV_UQ;
        if (r < CV_UKV) { const int kb = r >> 5, nb = r & 31, n0 = 64 * nb, hh = n0 >> 8, rr = n0 & 255;
            cv_tile(in[I_WUKV] + (size_t)e * KVL * 2048, 2048, (bf16*)(ws + WS_WUKV) + (size_t)e * 2048 * KVL, KVL, (rr < 128 ? 0 : 1024) + hh * 128 + (rr & 127), scr, 64 * kb, n0, lane, nullptr); return; } r -= CV_UKV;
        if (r < CV_O) { const int kb = r >> 5, nb = r & 31; cv_tile(in[I_WOA] + (size_t)e * D * D, D, (bf16*)(ws + WS_WOA) + (size_t)e * D * D, D, 64 * nb, scr, 64 * kb, 64 * nb, lane, nullptr); return; } r -= CV_O;
    }
    cv_ffn_item(in, ws, 1, l, r, scr, lane);
}
__device__ __forceinline__ void cv_group(const float* const CAS* in, unsigned char* ws, int g, unsigned* ctr, LAS unsigned char* scr, int lane) {
    const int n = cv_group_items(g);
    for (;;) { unsigned base = 0; if (lane == 0) base = atomicAdd(ctr, 4u); base = (unsigned)__builtin_amdgcn_readfirstlane((int)base);
        if ((int)base >= n) break;
        for (int j = 0; j < 4; ++j) if ((int)base + j < n) cv_group_item(in, ws, g, (int)base + j, scr, lane); }
}
__device__ __forceinline__ void x_row_init(const float* xin, bf16* brow, pg8::ssq_t* ss, int lane) {
    const GAS f32x4* xr = (const GAS f32x4*)xin + lane; GAS v2u* o8 = (GAS v2u*)brow + lane;
    float s = 0.f;
#pragma unroll
    for (int j = 0; j < 8; ++j) { const f32x4 v = xr[64 * j]; s += (v.x * v.x + v.y * v.y) + (v.z * v.z + v.w * v.w); v2u w; w.x = pk2(v.x, v.y); w.y = pk2(v.z, v.w); o8[64 * j] = w; }
    s = wave_sum(s);
    if (lane < 8) ss[lane] = lane == 0 ? s : 0.f;
}

namespace att {
constexpr int KROW = 400, VROW = 144;
constexpr int KBYTES = 64 * KROW, VBYTES = 128 * VROW, BUF = KBYTES + VBYTES;
constexpr int UNIT_OFF = 2 * BUF;
constexpr int NUNITS = DB * HEADS + NB * HEADS * 8;
constexpr float SC_LOG2E = 0.07216878364870322f * 1.44269504088896f;
static_assert(UNIT_OFF + 64 <= RING_BYTES, "attention LDS");

struct Stage { v4u kn[2]; v4u kp; v4u vt[2]; };

__device__ __forceinline__ void stage_load(Stage& s, const bf16* KN, const bf16* KP, const bf16* VTp, int kvrow, int h, int tid) {
    const GAS bf16* kn = (const GAS bf16*)(KN + (size_t)kvrow * 1024 + h * 128); const GAS bf16* kp = (const GAS bf16*)(KP + (size_t)kvrow * 64); const GAS bf16* vt = (const GAS bf16*)(VTp + (size_t)h * 128 * KVROWS + kvrow);
#pragma unroll
    for (int i = 0; i < 2; ++i) { const unsigned p = tid + 512 * i, off = (p >> 4) * 1024u + 8u * (p & 15); s.kn[i] = *(const GAS v4u*)(kn + off); }
    { const unsigned off = (unsigned)(tid >> 3) * 64u + 8u * (tid & 7); s.kp = *(const GAS v4u*)(kp + off); }
#pragma unroll
    for (int i = 0; i < 2; ++i) { const unsigned p = tid + 512 * i, off = (p >> 3) * (unsigned)KVROWS + 8u * (p & 7); s.vt[i] = *(const GAS v4u*)(vt + off); }
}
__device__ __forceinline__ void stage_store(const Stage& s, LAS unsigned char* buf, int tid) {
#pragma unroll
    for (int i = 0; i < 2; ++i) { const int p = tid + 512 * i, key = p >> 4, c = p & 15; *(LAS v4u*)(buf + key * KROW + c * 16) = s.kn[i]; }
    { const int key = tid >> 3, c = tid & 7; *(LAS v4u*)(buf + key * KROW + 256 + c * 16) = s.kp; }
#pragma unroll
    for (int i = 0; i < 2; ++i) { const int p = tid + 512 * i, dv = p >> 3, c = p & 7; *(LAS v4u*)(buf + KBYTES + dv * VROW + c * 16) = s.vt[i]; }
}

template <bool two>
__device__ __forceinline__ void attn_unit(int unit, LAS unsigned char* lds, const bf16* QB, const bf16* KN, const bf16* KP, const bf16* VTp, const float* rope, bf16* CAT, int tid, int wave, int lane) {
    const int fr = lane & 15, fq = lane >> 4;
    int h, qrow0, kvrow0, ntiles, wlimit, pos0; bool active;
    if constexpr (!two) { const int b = unit >> 3; h = unit & 7; qrow0 = MP + b * DSEQ; kvrow0 = MP + b * KVS; ntiles = KVS / 64; wlimit = ntiles; pos0 = PAST; active = wave < 4; }
    else { const int v = unit - DB * HEADS, qt = 7 - (v >> 7), bh = v & 127, b = bh >> 3; h = bh & 7; qrow0 = b * SEQ + 256 * qt; kvrow0 = b * SEQ; ntiles = 4 * qt + 4; wlimit = 4 * qt + (wave >> 1) + 1; pos0 = 256 * qt; active = true; }
    constexpr int rpw = two ? 32 : 16;
    bf16x8 q[2][6];
#pragma unroll
    for (int ks = 0; ks < 6; ++ks) q[1][ks] = (bf16x8){0, 0, 0, 0, 0, 0, 0, 0};
    if (active) {
#pragma unroll
        for (int rg = 0; rg < (two ? 2 : 1); ++rg) { const int rr = rpw * wave + 16 * rg + fr; const bf16* qp = QB + (size_t)(qrow0 + rr) * 1536 + h * QHD + 8 * fq;
#pragma unroll
            for (int ks = 0; ks < 6; ++ks) q[rg][ks] = *(const GAS bf16x8*)(qp + 32 * ks);
            const float* rp = rope + (size_t)(pos0 + rr) * 64 + 16 * fq;
#pragma unroll
            for (int j = 0; j < 8; ++j) { const float c = rp[2 * j], s = rp[2 * j + 1]; const float x1 = bf2f((unsigned short)q[rg][4][j]), x2 = bf2f((unsigned short)q[rg][5][j]);
                q[rg][4][j] = (short)f2bf(x1 * c - x2 * s); q[rg][5][j] = (short)f2bf(x1 * s + x2 * c); } }
    } else {
#pragma unroll
        for (int rg = 0; rg < 2; ++rg)
#pragma unroll
            for (int ks = 0; ks < 6; ++ks) q[rg][ks] = (bf16x8){0, 0, 0, 0, 0, 0, 0, 0};
    }
    f32x4 o[2][8]; float mrow[2], lrow[2];
#pragma unroll
    for (int rg = 0; rg < 2; ++rg) { mrow[rg] = -1e30f; lrow[rg] = 0.f;
#pragma unroll
        for (int n = 0; n < 8; ++n) o[rg][n] = (f32x4){0.f, 0.f, 0.f, 0.f}; }
    Stage st;
    stage_load(st, KN, KP, VTp, kvrow0, h, tid);
    stage_store(st, lds, tid);
    LDS_WAIT(); __syncthreads();
    for (int kt = 0; kt < ntiles; ++kt) {
        LAS unsigned char* cur = lds + (kt & 1) * BUF; LAS unsigned char* nxt = lds + ((kt + 1) & 1) * BUF;
        const bool more = kt + 1 < ntiles;
        if (more) stage_load(st, KN, KP, VTp, kvrow0 + 64 * (kt + 1), h, tid);
        if (active && kt < wlimit) {
            f32x4 s[2][4];
#pragma unroll
            for (int rg = 0; rg < 2; ++rg)
#pragma unroll
                for (int kk = 0; kk < 4; ++kk) s[rg][kk] = (f32x4){0.f, 0.f, 0.f, 0.f};
#pragma unroll
            for (int ks = 0; ks < 6; ++ks) {
                bf16x8 kf[4];
#pragma unroll
                for (int kk = 0; kk < 4; ++kk) kf[kk] = *(const LAS bf16x8*)(cur + (16 * kk + fr) * KROW + ks * 64 + fq * 16);
#pragma unroll
                for (int kk = 0; kk < 4; ++kk) {
                    s[0][kk] = __builtin_amdgcn_mfma_f32_16x16x32_bf16(kf[kk], q[0][ks], s[0][kk], 0, 0, 0);
                    if constexpr (two) s[1][kk] = __builtin_amdgcn_mfma_f32_16x16x32_bf16(kf[kk], q[1][ks], s[1][kk], 0, 0, 0); }
            }
            bf16x8 pb[2][2];
#pragma unroll
            for (int rg = 0; rg < (two ? 2 : 1); ++rg) {
                float mx = -1e30f;
#pragma unroll
                for (int kk = 0; kk < 4; ++kk) { s[rg][kk] = s[rg][kk] * SC_LOG2E; mx = fmaxf(mx, fmaxf(fmaxf(s[rg][kk][0], s[rg][kk][1]), fmaxf(s[rg][kk][2], s[rg][kk][3]))); }
                mx = fmaxf(mx, __shfl_xor(mx, 16)); mx = fmaxf(mx, __shfl_xor(mx, 32));
                const float mnew = fmaxf(mrow[rg], mx), alpha = __builtin_amdgcn_exp2f(mrow[rg] - mnew); mrow[rg] = mnew;
                float ps = 0.f;
#pragma unroll
                for (int kk = 0; kk < 4; ++kk)
#pragma unroll
                    for (int j = 0; j < 4; ++j) { const float p = __builtin_amdgcn_exp2f(s[rg][kk][j] - mnew); s[rg][kk][j] = p; ps += p; }
                lrow[rg] = lrow[rg] * alpha + ps;
#pragma unroll
                for (int n = 0; n < 8; ++n) o[rg][n] = o[rg][n] * alpha;
#pragma unroll
                for (int k2 = 0; k2 < 2; ++k2) { v4u w; w.x = pg8::cvt_pk_bf16(s[rg][2 * k2][0], s[rg][2 * k2][1]); w.y = pg8::cvt_pk_bf16(s[rg][2 * k2][2], s[rg][2 * k2][3]);
                    w.z = pg8::cvt_pk_bf16(s[rg][2 * k2 + 1][0], s[rg][2 * k2 + 1][1]); w.w = pg8::cvt_pk_bf16(s[rg][2 * k2 + 1][2], s[rg][2 * k2 + 1][3]); pb[rg][k2] = __builtin_bit_cast(bf16x8, w); }
            }
            if constexpr (!two) { pb[1][0] = (bf16x8){0, 0, 0, 0, 0, 0, 0, 0}; pb[1][1] = (bf16x8){0, 0, 0, 0, 0, 0, 0, 0}; }
            const LAS unsigned char* vb = cur + KBYTES;
#pragma unroll
            for (int n = 0; n < 8; ++n) {
                v2u vr[2][2];
#pragma unroll
                for (int k2 = 0; k2 < 2; ++k2) { const LAS unsigned char* vp = vb + (16 * n + fr) * VROW + k2 * 64 + fq * 8; vr[k2][0] = *(const LAS v2u*)vp; vr[k2][1] = *(const LAS v2u*)(vp + 32); }
#pragma unroll
                for (int k2 = 0; k2 < 2; ++k2) { const v4u w = {vr[k2][0].x, vr[k2][0].y, vr[k2][1].x, vr[k2][1].y}; const bf16x8 vf = __builtin_bit_cast(bf16x8, w);
                    o[0][n] = __builtin_amdgcn_mfma_f32_16x16x32_bf16(vf, pb[0][k2], o[0][n], 0, 0, 0);
                    if constexpr (two) o[1][n] = __builtin_amdgcn_mfma_f32_16x16x32_bf16(vf, pb[1][k2], o[1][n], 0, 0, 0); }
            }
        }
        if (more) stage_store(st, nxt, tid);
        LDS_WAIT(); __syncthreads();
    }
    if (active) {
#pragma unroll
        for (int rg = 0; rg < (two ? 2 : 1); ++rg) { float l = lrow[rg]; l += __shfl_xor(l, 16); l += __shfl_xor(l, 32); const float inv = 1.0f / l;
            bf16* op = CAT + (size_t)(qrow0 + rpw * wave + 16 * rg + fr) * D + DCONV + h * VD + 4 * fq;
#pragma unroll
            for (int n = 0; n < 8; ++n) { v2u w; w.x = pg8::cvt_pk_bf16(o[rg][n][0] * inv, o[rg][n][1] * inv); w.y = pg8::cvt_pk_bf16(o[rg][n][2] * inv, o[rg][n][3] * inv); *(GAS v2u*)(op + 16 * n) = w; } }
    }
}
}

namespace gla {
#define WG_SYNC() do { asm volatile("s_waitcnt lgkmcnt(0)" ::: "memory"); __builtin_amdgcn_s_barrier(); asm volatile("" ::: "memory"); } while (0)
constexpr int ROWD = 272, ROWT = 144;
constexpr int KEND = 0, QT = KEND + 64 * ROWD, QJ = QT + 64 * ROWD, KLT = QJ + 160 * ROWD, VT = KLT + 128 * ROWT, SC = VT + 128 * ROWT, TOT = SC + 64 * ROWT, EAL = TOT + 2048, SSQ = EAL + 512, UNIT = SSQ + 2048, END = UNIT + 64;
static_assert(END <= RING_BYTES, "gla LDS");
constexpr int NUNITS = NB * HGH + DB * HGH;

__device__ __forceinline__ void load_raw(unsigned (&rq)[16], unsigned (&rg)[16], unsigned (&rv)[16], const bf16* zrow, int d) {
#pragma unroll
    for (int r = 0; r < 16; ++r) { const GAS bf16* p = (const GAS bf16*)(zrow + (size_t)r * DINC + d); rq[r] = p[0]; rg[r] = p[2048]; rv[r] = p[4096]; }
}

__device__ __forceinline__ void gla_unit(int unit, LAS unsigned char* lds, const bf16* ZC, const float* S0all  , const float* g_o, bf16* OB, float* hg_p  , float* hg_s  , int tid, int wave, int lane) {
    const int fr = lane & 15, fq = lane >> 4, d = tid & 127, sb = tid >> 7;
    const bool smp = unit >= NB * HGH;
    const int u2 = smp ? unit - NB * HGH : unit, b = u2 >> 4, h = u2 & 15;
    const int nch = smp ? 1 : SEQ / 64, row0 = smp ? MP + b * DSEQ : b * SEQ;
    float* sout = smp ? hg_s + ((size_t)(b * HGH + h) << 14) : hg_p + ((size_t)(b * HGH + h) << 14);
    f32x4 S[8];
    if (smp) { const float* s0 = S0all + ((size_t)(b * HGH + h) << 14) + 16 * wave + fr;
#pragma unroll
        for (int a = 0; a < 8; ++a)
#pragma unroll
            for (int e = 0; e < 4; ++e) S[a][e] = s0[(16 * a + 4 * fq + e) * 128]; }
    else {
#pragma unroll
        for (int a = 0; a < 8; ++a) S[a] = (f32x4){0.f, 0.f, 0.f, 0.f}; }
    float gov[4];
#pragma unroll
    for (int e = 0; e < 4; ++e) gov[e] = g_o[16 * wave + 4 * fq + e];
    unsigned rq[16], rg[16], rv[16];
    load_raw(rq, rg, rv, ZC + (size_t)(row0 + 16 * sb) * DINC + h * 128, d);
    LAS float* tot = (LAS float*)(lds + TOT); LAS float* eal = (LAS float*)(lds + EAL); LAS float* ssq = (LAS float*)(lds + SSQ);
    for (int c = 0; c < nch; ++c) {
        float fx[16], e1[16], bk[16];
        { float run = 0.f;
#pragma unroll
          for (int r = 0; r < 16; ++r) { const float g = bf2f(rg[r]); run += g; fx[r] = __builtin_amdgcn_exp2f(g * 1.44269504089f); }
          tot[sb * 128 + d] = run; }
        e1[0] = fx[0]; bk[15] = 1.0f;
#pragma unroll
        for (int r = 1; r < 16; ++r) { e1[r] = e1[r - 1] * fx[r]; bk[15 - r] = bk[16 - r] * fx[16 - r]; }
        WG_SYNC();
        float P[5]; P[0] = 0.f;
#pragma unroll
        for (int j = 0; j < 4; ++j) P[j + 1] = P[j] + tot[j * 128 + d];
        float Pi = 0.f, Pi1 = 0.f;
#pragma unroll
        for (int j = 0; j < 4; ++j) if (j == sb) { Pi = P[j]; Pi1 = P[j + 1]; }
        const float alast = P[4];
        const float e_tail = __expf(alast - Pi1);
        const float e_head = __expf(Pi);
        float Fj[3];
#pragma unroll
        for (int j = 0; j < 3; ++j) Fj[j] = __expf(Pi - P[j + 1]);
        if (sb == 0) eal[d] = __expf(alast);
        unsigned klt[8], vtt[8];
        LAS unsigned char* const kend_p = lds + KEND + (16 * sb) * ROWD + d * 2;
        LAS unsigned char* const qt_p = lds + QT + (16 * sb) * ROWD + d * 2;
#pragma unroll
        for (int r = 0; r < 16; r += 2) {
            float kl[2];
#pragma unroll
            for (int h2 = 0; h2 < 2; ++h2) { const int rr = r + h2;
                const float qv = bf2f(rq[rr]), kend = (1.0f - fx[rr]) * bk[rr], qe = qv * e1[rr];
                kl[h2] = kend * e_tail;
                const unsigned w = pg8::cvt_pk_bf16(kend, qe * e_head);
                *(LAS unsigned short*)(kend_p + rr * ROWD) = (unsigned short)w; *(LAS unsigned short*)(qt_p + rr * ROWD) = (unsigned short)(w >> 16);
                const float qd = qv * __builtin_amdgcn_rcpf(fmaxf(bk[rr], 1e-30f));
                if (sb == 0) { *(LAS unsigned short*)(lds + QJ + (0 + rr) * ROWD + d * 2) = (unsigned short)pg8::cvt_pk_bf16(qd, 0.f); }
                else if (sb == 1) { const unsigned u = pg8::cvt_pk_bf16(qe * Fj[0], qd);
                    *(LAS unsigned short*)(lds + QJ + (16 + rr) * ROWD + d * 2) = (unsigned short)u; *(LAS unsigned short*)(lds + QJ + (64 + rr) * ROWD + d * 2) = (unsigned short)(u >> 16); }
                else if (sb == 2) { const unsigned u = pg8::cvt_pk_bf16(qe * Fj[0], qe * Fj[1]), u2 = pg8::cvt_pk_bf16(qd, 0.f);
                    *(LAS unsigned short*)(lds + QJ + (32 + rr) * ROWD + d * 2) = (unsigned short)u; *(LAS unsigned short*)(lds + QJ + (64 + 16 + rr) * ROWD + d * 2) = (unsigned short)(u >> 16);
                    *(LAS unsigned short*)(lds + QJ + (112 + rr) * ROWD + d * 2) = (unsigned short)u2; }
                else { const unsigned u = pg8::cvt_pk_bf16(qe * Fj[0], qe * Fj[1]), u2 = pg8::cvt_pk_bf16(qe * Fj[2], qd);
                    *(LAS unsigned short*)(lds + QJ + (48 + rr) * ROWD + d * 2) = (unsigned short)u; *(LAS unsigned short*)(lds + QJ + (64 + 32 + rr) * ROWD + d * 2) = (unsigned short)(u >> 16);
                    *(LAS unsigned short*)(lds + QJ + (112 + 16 + rr) * ROWD + d * 2) = (unsigned short)u2; *(LAS unsigned short*)(lds + QJ + (144 + rr) * ROWD + d * 2) = (unsigned short)(u2 >> 16); }
            }
            klt[r >> 1] = pg8::cvt_pk_bf16(kl[0], kl[1]); vtt[r >> 1] = (unsigned)rv[r] | ((unsigned)rv[r + 1] << 16);
        }
        { LAS v4u* kp = (LAS v4u*)(lds + KLT + d * ROWT + sb * 32); kp[0] = (v4u){klt[0], klt[1], klt[2], klt[3]}; kp[1] = (v4u){klt[4], klt[5], klt[6], klt[7]};
          LAS v4u* vp = (LAS v4u*)(lds + VT + d * ROWT + sb * 32); vp[0] = (v4u){vtt[0], vtt[1], vtt[2], vtt[3]}; vp[1] = (v4u){vtt[4], vtt[5], vtt[6], vtt[7]}; }
        WG_SYNC();
        v2u gate[4];
#pragma unroll
        for (int tt = 0; tt < 4; ++tt) gate[tt] = *(const GAS v2u*)(ZC + (size_t)(row0 + 64 * c + 16 * tt + fr) * DINC + 6144 + h * 128 + 16 * wave + 4 * fq);
        asm volatile("" ::: "memory");
        { const int cn = c + 1 < nch ? c + 1 : c;
          load_raw(rq, rg, rv, ZC + (size_t)(row0 + 64 * cn + 16 * sb) * DINC + h * 128, d); }
#pragma unroll
        for (int rep = 0; rep < 2; ++rep) {
            const int task = wave + 8 * rep;
            if (task < 12) {
                int ti, tj; bool zero = false;
                switch (task) { case 0: ti = 0; tj = 0; break; case 1: ti = 1; tj = 0; break; case 2: ti = 1; tj = 1; break; case 3: ti = 2; tj = 0; break; case 4: ti = 2; tj = 1; break; case 5: ti = 2; tj = 2; break;
                                case 6: ti = 3; tj = 0; break; case 7: ti = 3; tj = 1; break; case 8: ti = 3; tj = 2; break; case 9: ti = 3; tj = 3; break; case 10: ti = 0; tj = 1; zero = true; break; default: ti = 2; tj = 3; zero = true; break; }
                f32x4 sacc = (f32x4){0.f, 0.f, 0.f, 0.f};
                if (!zero) {
                    const int rowb = (tj == 0 ? 0 : tj == 1 ? 64 : tj == 2 ? 112 : 144) + 16 * (ti - tj);
#pragma unroll
                    for (int ks = 0; ks < 4; ++ks) { const bf16x8 af = *(const LAS bf16x8*)(lds + KEND + (16 * tj + fr) * ROWD + ks * 64 + fq * 16);
                        const bf16x8 bfm = *(const LAS bf16x8*)(lds + QJ + (rowb + fr) * ROWD + ks * 64 + fq * 16);
                        sacc = __builtin_amdgcn_mfma_f32_16x16x32_bf16(af, bfm, sacc, 0, 0, 0); }
                    if (ti == tj) {
#pragma unroll
                        for (int e = 0; e < 4; ++e) if (4 * fq + e > fr) sacc[e] = 0.f; }
                }
                v2u w; w.x = pg8::cvt_pk_bf16(sacc[0], sacc[1]); w.y = pg8::cvt_pk_bf16(sacc[2], sacc[3]);
                *(LAS v2u*)(lds + SC + (16 * ti + fr) * ROWT + (16 * tj + 4 * fq) * 2) = w;
            }
        }
        f32x4 oacc[4];
#pragma unroll
        for (int tt = 0; tt < 4; ++tt) oacc[tt] = (f32x4){0.f, 0.f, 0.f, 0.f};
#pragma unroll
        for (int kp = 0; kp < 4; ++kp) {
            v4u w; w.x = pg8::cvt_pk_bf16(S[2 * kp][0], S[2 * kp][1]); w.y = pg8::cvt_pk_bf16(S[2 * kp][2], S[2 * kp][3]); w.z = pg8::cvt_pk_bf16(S[2 * kp + 1][0], S[2 * kp + 1][1]); w.w = pg8::cvt_pk_bf16(S[2 * kp + 1][2], S[2 * kp + 1][3]);
            const bf16x8 af = __builtin_bit_cast(bf16x8, w);
#pragma unroll
            for (int tt = 0; tt < 4; ++tt) { const LAS unsigned char* qp = lds + QT + (16 * tt + fr) * ROWD + (32 * kp + 4 * fq) * 2;
                const v2u lo = *(const LAS v2u*)qp, hi = *(const LAS v2u*)(qp + 32); const v4u qw = {lo.x, lo.y, hi.x, hi.y};
                oacc[tt] = __builtin_amdgcn_mfma_f32_16x16x32_bf16(af, __builtin_bit_cast(bf16x8, qw), oacc[tt], 0, 0, 0); }
        }
        bf16x8 vf[2];
#pragma unroll
        for (int ks = 0; ks < 2; ++ks) vf[ks] = *(const LAS bf16x8*)(lds + VT + (16 * wave + fr) * ROWT + ks * 64 + fq * 16);
#pragma unroll
        for (int a = 0; a < 8; ++a) { const f32x4 dec = *(const LAS f32x4*)(lds + EAL + (16 * a + 4 * fq) * 4); S[a] = S[a] * dec;
#pragma unroll
            for (int ks = 0; ks < 2; ++ks) { const bf16x8 af = *(const LAS bf16x8*)(lds + KLT + (16 * a + fr) * ROWT + ks * 64 + fq * 16);
                S[a] = __builtin_amdgcn_mfma_f32_16x16x32_bf16(af, vf[ks], S[a], 0, 0, 0); } }
        WG_SYNC();
#pragma unroll
        for (int tt = 0; tt < 4; ++tt) {
#pragma unroll
            for (int ks = 0; ks < 2; ++ks) if (ks == 0 || tt >= 2) { const bf16x8 bfm = *(const LAS bf16x8*)(lds + SC + (16 * tt + fr) * ROWT + ks * 64 + fq * 16);
                oacc[tt] = __builtin_amdgcn_mfma_f32_16x16x32_bf16(vf[ks], bfm, oacc[tt], 0, 0, 0); }
            float q2 = (oacc[tt][0] * oacc[tt][0] + oacc[tt][1] * oacc[tt][1]) + (oacc[tt][2] * oacc[tt][2] + oacc[tt][3] * oacc[tt][3]);
            q2 += __shfl_xor(q2, 16); q2 += __shfl_xor(q2, 32);
            if (fq == 0) ssq[wave * 64 + 16 * tt + fr] = q2;
        }
        WG_SYNC();
#pragma unroll
        for (int tt = 0; tt < 4; ++tt) { float q2 = 0.f;
#pragma unroll
            for (int w = 0; w < 8; ++w) q2 += ssq[w * 64 + 16 * tt + fr];
            const float rstd = __builtin_amdgcn_rsqf(q2 * (1.f / 128.f) + EPS);
            v2u w; w.x = pg8::cvt_pk_bf16(oacc[tt][0] * rstd * gov[0] * bflo(gate[tt].x), oacc[tt][1] * rstd * gov[1] * bfhi(gate[tt].x)); w.y = pg8::cvt_pk_bf16(oacc[tt][2] * rstd * gov[2] * bflo(gate[tt].y), oacc[tt][3] * rstd * gov[3] * bfhi(gate[tt].y));
            *(GAS v2u*)(OB + (size_t)(row0 + 64 * c + 16 * tt + fr) * D + h * 128 + 16 * wave + 4 * fq) = w; }
    }
#pragma unroll
    for (int a = 0; a < 8; ++a)
#pragma unroll
        for (int e = 0; e < 4; ++e) sout[(16 * a + 4 * fq + e) * 128 + 16 * wave + fr] = S[a][e];
    __syncthreads();
}
}

__device__ __forceinline__ void load8f(const bf16* p, float (&v)[8]) { const v4u w = *(const GAS v4u*)p; v[0] = bflo(w.x); v[1] = bfhi(w.x); v[2] = bflo(w.y); v[3] = bfhi(w.y); v[4] = bflo(w.z); v[5] = bfhi(w.z); v[6] = bflo(w.w); v[7] = bfhi(w.w); }
__device__ __forceinline__ void cu_row(const bf16* zrow, int c0, float (&cu)[8]) { float a[8], b[8]; load8f(zrow + 1024 + c0, a); load8f(zrow + 2048 + c0, b);
#pragma unroll
    for (int j = 0; j < 8; ++j) cu[j] = a[j] * b[j]; }
__device__ __forceinline__ void mixa_conv_strip(int m0, int e, const bf16* ZA, const float* cache_conv, const float* w_conv, bf16* CAT, float* out, int lane) {
    const bool smp = m0 >= MP; const int mm = smp ? m0 - MP : m0;
    const int b = smp ? mm >> 6 : mm >> 11, t0 = smp ? mm & 63 : mm & 2047, T = smp ? DSEQ : SEQ;
    const float* wc = w_conv + (size_t)e * 3 * DCONV;
#pragma unroll
    for (int half = 0; half < 2; ++half) {
        const int c0 = 512 * half + 8 * lane;
        float cu1[8], cu2[8], w0[8], w1[8], w2[8];
#pragma unroll
        for (int j = 0; j < 8; ++j) { w0[j] = wc[c0 + j]; w1[j] = wc[DCONV + c0 + j]; w2[j] = wc[2 * DCONV + c0 + j]; }
        if (t0 >= 2) { cu_row(ZA + (size_t)(m0 - 1) * DINA_P, c0, cu1); cu_row(ZA + (size_t)(m0 - 2) * DINA_P, c0, cu2); }
        else {
#pragma unroll
            for (int j = 0; j < 8; ++j) { cu1[j] = smp ? cache_conv[((size_t)(e * DB + b) * 2 + 1) * DCONV + c0 + j] : 0.f; cu2[j] = smp ? cache_conv[((size_t)(e * DB + b) * 2 + 0) * DCONV + c0 + j] : 0.f; } }
#pragma unroll
        for (int r = 0; r < 4; ++r) { const int m = m0 + r, t = t0 + r; const bf16* zrow = ZA + (size_t)m * DINA_P;
            float gb[8], cu0[8], y[8];
            load8f(zrow + c0, gb); cu_row(zrow, c0, cu0);
#pragma unroll
            for (int j = 0; j < 8; ++j) y[j] = gb[j] * (w0[j] * cu2[j] + w1[j] * cu1[j] + w2[j] * cu0[j]);
            v4u w; w.x = pk2(y[0], y[1]); w.y = pk2(y[2], y[3]); w.z = pk2(y[4], y[5]); w.w = pk2(y[6], y[7]);
            *(GAS v4u*)(CAT + (size_t)m * D + c0) = w;
            if (t >= T - 2) { float* cs = out + (smp ? O_CONVS + ((size_t)(e * DB + b) * 2 + (t - (T - 2))) * DCONV : O_CONVP + ((size_t)(e * NB + b) * 2 + (t - (T - 2))) * DCONV) + c0;
                *(GAS f32x4*)cs = (f32x4){cu0[0], cu0[1], cu0[2], cu0[3]}; *(GAS f32x4*)(cs + 4) = (f32x4){cu0[4], cu0[5], cu0[6], cu0[7]}; }
#pragma unroll
            for (int j = 0; j < 8; ++j) { cu2[j] = cu1[j]; cu1[j] = cu0[j]; }
        }
    }
}
__device__ __forceinline__ void mixa_row(int m, int e, const bf16* ZA, const float* g_q, const float* g_kv, const float* rope,
                                         bf16* CQN, bf16* KVIN, bf16* KPEB, float* out, int lane) {
    const bool smp = m >= MP; const int mm = smp ? m - MP : m;
    const int b = smp ? mm >> 6 : mm >> 11, t = smp ? mm & 63 : mm & 2047;
    const int kvrow = smp ? MP + b * KVS + PAST + t : m, pos = smp ? PAST + t : t;
    const bf16* zrow = ZA + (size_t)m * DINA_P;
    {
        float v[8]; load8f(zrow + 3072 + 8 * lane, v); float s = 0.f;
#pragma unroll
        for (int j = 0; j < 8; ++j) s += v[j] * v[j];
        const float rstd = 1.0f / sqrtf(wave_sum(s) * (1.f / QL) + EPS); const float* g = g_q + e * QL + 8 * lane;
        v4u w; w.x = pk2(v[0] * rstd * g[0], v[1] * rstd * g[1]); w.y = pk2(v[2] * rstd * g[2], v[3] * rstd * g[3]); w.z = pk2(v[4] * rstd * g[4], v[5] * rstd * g[5]); w.w = pk2(v[6] * rstd * g[6], v[7] * rstd * g[7]);
        *(GAS v4u*)(CQN + (size_t)m * QL + 8 * lane) = w;
    }
    {
        float v[8]; load8f(zrow + 3584 + 8 * lane, v); float s = 0.f;
#pragma unroll
        for (int j = 0; j < 8; ++j) s += v[j] * v[j];
        const float rstd = 1.0f / sqrtf(wave_sum(s) * (1.f / KVL) + EPS); const float* g = g_kv + e * KVL + 8 * lane;
#pragma unroll
        for (int j = 0; j < 8; ++j) v[j] = v[j] * rstd * g[j];
        v4u w; w.x = pk2(v[0], v[1]); w.y = pk2(v[2], v[3]); w.z = pk2(v[4], v[5]); w.w = pk2(v[6], v[7]);
        *(GAS v4u*)(KVIN + (size_t)kvrow * KVL + 8 * lane) = w;
        float* co = out + (smp ? O_CKVS + ((size_t)(e * DB + b) * DSEQ + t) * KVL : O_CKVP + ((size_t)(e * NB + b) * SEQ + t) * KVL) + 8 * lane;
        *(GAS f32x4*)co = (f32x4){v[0], v[1], v[2], v[3]}; *(GAS f32x4*)(co + 4) = (f32x4){v[4], v[5], v[6], v[7]};
    }
    if (lane < 32) {
        const float x1 = bf2f(zrow[4096 + lane]), x2 = bf2f(zrow[4096 + 32 + lane]);
        const float c = rope[(size_t)pos * 64 + 2 * lane], s = rope[(size_t)pos * 64 + 2 * lane + 1];
        const float r1 = x1 * c - x2 * s, r2 = x1 * s + x2 * c;
        float* ko = out + (smp ? O_KPES + ((size_t)(e * DB + b) * DSEQ + t) * ROPE : O_KPEP + ((size_t)(e * NB + b) * SEQ + t) * ROPE);
        ko[lane] = r1; ko[32 + lane] = r2;
        KPEB[(size_t)kvrow * ROPE + lane] = (bf16)f2bf(r1); KPEB[(size_t)kvrow * ROPE + 32 + lane] = (bf16)f2bf(r2);
    }
}

#ifndef REP_ATT
#define REP_ATT 1
#endif
#ifndef REP_GLA
#define REP_GLA 1
#endif
#ifndef REP_MIXA
#define REP_MIXA 1
#endif
#ifndef REP_NORM
#define REP_NORM 1
#endif
#ifndef REP_PRO
#define REP_PRO 1
#endif
#ifndef REP_GU
#define REP_GU 1
#endif
#ifndef STAG_ON
#define STAG_ON 0
#endif
#ifndef STAG_GU
#define STAG_GU 100
#endif
#ifndef STAG_RES
#define STAG_RES 250
#endif
#ifndef STAG_IN
#define STAG_IN 150
#endif
#ifndef WGM_GU
#define WGM_GU 4
#endif
#ifndef MK_ONE_LAUNCH
#define MK_ONE_LAUNCH 1
#endif
constexpr int N_PHASES = 1 + 8 * 2 + 2 * 5 + 2 * 3 + 1;

#define PH_LOCALS \
    const CAS Args* ap_ = (const CAS Args*)__builtin_amdgcn_kernarg_segment_ptr(); asm volatile("" : "+s"(ap_)); const CAS Args& args = *ap_;   \
    int tid = threadIdx.x; asm volatile("" : "+v"(tid)); const int lane = tid & 63, wave = __builtin_amdgcn_readfirstlane(tid >> 6); \
    GAS unsigned char* ws_ = (GAS unsigned char*)args.ws; asm volatile("" : "+s"(ws_)); unsigned char* ws = (unsigned char*)ws_;   \
    GAS float* X_ = (GAS float*)args.out; asm volatile("" : "+s"(X_)); float* X = (float*)X_; \
    int G = gridDim.x; asm volatile("" : "+s"(G)); int bid = blockIdx.x; asm volatile("" : "+s"(bid)); \
    const int gw = bid * NWAVES + wave, NGW = G * NWAVES; LAS unsigned char* lds = (LAS unsigned char*)lds_raw; \
    bf16* XN = (bf16*)(ws + WS_XN); bf16* CAT = (bf16*)(ws + WS_CAT); pg8::ssq_t* SSQ = (pg8::ssq_t*)(ws + WS_SS); (void)lane; (void)gw; (void)NGW; (void)XN; (void)CAT; (void)SSQ; (void)X; (void)lds;

#define PH_L int lq_ = l; asm volatile("" : "+s"(lq_)); const int l = lq_; const int e = l >> 1, o = l >> 1; (void)e; (void)o;
__global__ void __launch_bounds__(NTHR, 2) mega_fwd(Args kargs) {
    extern __shared__ __attribute__((aligned(16))) unsigned char lds_raw[];
    XcdBarrier bar;
    {
        volatile LAS unsigned* MISC = (volatile LAS unsigned*)((LAS unsigned char*)lds_raw + MISC_OFF);
        if (threadIdx.x < 32) MISC[threadIdx.x] = 0u;
        __syncthreads();
        bar.bar = (unsigned*)(kargs.ws + WS_CTL) + CW_BAR; bar.x = 0; bar.st = nullptr;
        if (MK_ONE_LAUNCH) bar = xcd_barrier_post((unsigned*)(kargs.ws + WS_CTL) + CW_BAR, MISC + 8);
    }
    const int lo = kargs.ph_lo, hi = kargs.ph_hi;
    int ph = 0;
#define IN_PHASE (ph >= lo && ph < hi)
#define STAGGER(T_) do { if (STAG_ON) { const unsigned long long t0_ = __builtin_amdgcn_s_memrealtime(); const unsigned long long d_ = (unsigned long long)((blockIdx.x >> 3) & 3u) * (T_); while (__builtin_amdgcn_s_memrealtime() - t0_ < d_) __builtin_amdgcn_s_sleep(2); } } while (0)
#define END_PHASE do { if (MK_ONE_LAUNCH && ph + 1 < hi && ph + 1 < N_PHASES) { XcdBarrier b2_ = bar; GAS unsigned* bb_ = (GAS unsigned*)bar.bar; asm volatile("" : "+s"(bb_)); b2_.bar = (unsigned*)bb_; asm volatile("" : "+s"(b2_.x)); xcd_barrier(b2_); } ++ph; } while (0)

    if (IN_PHASE) {
        PH_LOCALS
        cv_group(args.in, ws, 0, (unsigned*)(ws + WS_CTL) + CW_CONV, lds + RING_OFF + wave * 16384, lane);
        const size_t gt = (size_t)bid * NTHR + tid, GT = (size_t)G * NTHR;
        for (size_t i = gt; i < (size_t)2 * (DINA_P - DINA) * D / 8; i += GT) { const size_t e = i / ((DINA_P - DINA) * D / 8), j = i % ((DINA_P - DINA) * D / 8);
            *(GAS v4u*)((bf16*)(ws + WS_WINA) + e * DINA_P * D + (size_t)DINA * D + j * 8) = (v4u){0u, 0u, 0u, 0u}; }
        for (int m = gw; m < M; m += NGW) x_row_init(m < MP ? args.in[I_XP] + (size_t)m * D : args.in[I_XS] + (size_t)(m - MP) * D, XN + (size_t)m * D, SSQ + (size_t)m * 8, lane);
        for (size_t i = gt; i < (size_t)KVS * 32; i += GT) { const int pos = (int)(i >> 5), k = (int)(i & 31); const double inv = exp(-(double)k * (9.210340371976184 / 32.0)), ang = (double)pos * inv;
            float* rp = (float*)(ws + WS_ROPE) + 2 * i; rp[0] = (float)cos(ang); rp[1] = (float)sin(ang); }
        for (size_t i = gt; i < 2048; i += GT) { const float a = args.in[I_LB][i], b2 = args.in[I_LB][2048 + i]; float* lbp = (float*)(ws + WS_LB);
            lbp[i] = 0.f; lbp[2048 + i] = 1.0f / (1.0f + expf(a - b2)); }
    }
    END_PHASE;

#define FFN_STEP(F_) { \
        if (IN_PHASE) { PH_LOCALS PH_L const int inst = (F_) * 4 + l; pg8::Gemm g{XN, (const bf16*)(ws + WS_WGU) + (size_t)inst * 2 * DFF * D, M, 2 * DFF, D, D, D}; pg8::StaticOrder S; S.init(M, 2 * DFF, G, bid, WGM_GU); \
            pg8::EpiSwiGLU E{(bf16*)(ws + WS_H), DFF, SSQ + (size_t)(3 * l + 2 * (F_)) * M * 8}; STAGGER(STAG_GU); for (int rep_ = 0; rep_ < REP_GU; ++rep_) pg8::gemm_phase<pg8::EpiSwiGLU, pg8::StaticOrder, true, true>(lds + RING_OFF, g, S, E); } \
        END_PHASE; \
        if (IN_PHASE) { PH_LOCALS PH_L const int inst = (F_) * 4 + l; pg8::Gemm g{(const bf16*)(ws + WS_H), (const bf16*)(ws + WS_WD) + (size_t)inst * D * DFF, M, D, DFF, DFF, DFF}; pg8::StaticOrder S; S.init(M, D, G, bid); \
            const int site = 3 * l + 2 * (F_) + 1; pg8::EpiResidNorm E{XN, SSQ + (size_t)site * M * 8, D, 0.5f, (PG8_LAS float*)(lds + EPI_P_OFF)}; STAGGER(STAG_RES); pg8::gemm_phase<pg8::EpiResidNorm, pg8::StaticOrder, true, true>(lds + RING_OFF, g, S, E); \
            const int cg = 1 + 2 * l + (F_); if (cg < 8) cv_group(args.in, ws, cg, (unsigned*)(ws + WS_CTL) + CW_CONV + 64 * cg, lds + RING_OFF + wave * 16384, lane); } \
        END_PHASE; }

    for (int l = 0; l < DEPTH; ++l) {
        FFN_STEP(0)
        if ((l & 1) == 0) {
            const int e = l >> 1;
            if (IN_PHASE) { PH_LOCALS PH_L pg8::Gemm g{XN, (const bf16*)(ws + WS_WINA) + (size_t)e * DINA_P * D, M, DINA_P, D, D, D}; pg8::StaticOrder S; S.init(M, DINA_P, G, bid);
                pg8::EpiStore E{(bf16*)(ws + WS_ZA), DINA_P, SSQ + (size_t)(3 * l + 1) * M * 8}; STAGGER(STAG_IN); pg8::gemm_phase<pg8::EpiStore, pg8::StaticOrder, true, true>(lds + RING_OFF, g, S, E); }
            END_PHASE;
            if (IN_PHASE) { PH_LOCALS PH_L
                bf16* ZA = (bf16*)(ws + WS_ZA); bf16* CQN = (bf16*)(ws + WS_CQN); bf16* KVIN = (bf16*)(ws + WS_KVIN); bf16* KPEB = (bf16*)(ws + WS_KPEB); const float* rope = (const float*)(ws + WS_ROPE);
                for (int rep = 0; rep < REP_MIXA; ++rep)
                for (int st = gw; st < M / 4; st += NGW) { mixa_conv_strip(4 * st, e, ZA, args.in[I_CCONV], args.in[I_WCONV], CAT, X, lane);
                    for (int r = 0; r < 4; ++r) mixa_row(4 * st + r, e, ZA, args.in[I_GQ], args.in[I_GKV], rope, CQN, KVIN, KPEB, X, lane); }
                for (int r = gw; r < DB * PAST; r += NGW) { const int b = r >> 12, s = r & 4095; const size_t kvrow = (size_t)MP + (size_t)b * KVS + s;
                    const float* src = args.in[I_CCKV] + ((size_t)(e * DB + b) * PAST + s) * KVL + 8 * lane; const f32x4 a = *(const GAS f32x4*)src, c = *(const GAS f32x4*)(src + 4);
                    v4u w; w.x = pk2(a.x, a.y); w.y = pk2(a.z, a.w); w.z = pk2(c.x, c.y); w.w = pk2(c.z, c.w); *(GAS v4u*)(KVIN + kvrow * KVL + 8 * lane) = w;
                    KPEB[kvrow * ROPE + lane] = (bf16)f2bf(args.in[I_CKPE][((size_t)(e * DB + b) * PAST + s) * ROPE + lane]); }
            }
            END_PHASE;
            if (IN_PHASE) { PH_LOCALS PH_L
                { pg8::Gemm g{(const bf16*)(ws + WS_CQN), (const bf16*)(ws + WS_WUQ) + (size_t)e * 1536 * QL, M, 1536, QL, QL, QL}; pg8::StaticOrder S; S.init(M, 1536, G, bid);
                  pg8::EpiStore E{(bf16*)(ws + WS_QB), 1536, nullptr}; pg8::gemm_phase<pg8::EpiStore, pg8::StaticOrder, true, true>(lds + RING_OFF, g, S, E); }
                { pg8::Gemm g{(const bf16*)(ws + WS_KVIN), (const bf16*)(ws + WS_WUKV) + (size_t)e * 2048 * KVL, KVROWS, 1024, KVL, KVL, KVL}; pg8::StaticOrder S; S.init(KVROWS, 1024, G, bid);
                  pg8::EpiStore E{(bf16*)(ws + WS_KNOPE), 1024, nullptr}; pg8::gemm_phase<pg8::EpiStore, pg8::StaticOrder, true, true>(lds + RING_OFF, g, S, E); }
                { pg8::Gemm g{(const bf16*)(ws + WS_WUKV) + (size_t)e * 2048 * KVL + (size_t)1024 * KVL, (const bf16*)(ws + WS_KVIN), 1024, KVROWS, KVL, KVL, KVL}; pg8::StaticOrder S; S.init(1024, KVROWS, G, bid);
                  pg8::EpiStore E{(bf16*)(ws + WS_VT), KVROWS, nullptr}; pg8::gemm_phase<pg8::EpiStore, pg8::StaticOrder, true, true>(lds + RING_OFF, g, S, E); }
            }
            END_PHASE;
            if (IN_PHASE) { PH_LOCALS PH_L
                for (int rep = 0; rep < REP_ATT; ++rep) {
                unsigned* ctr = (unsigned*)(ws + WS_CTL) + CW_ATTN + 64 * e + 1024 * rep;
                LAS unsigned* uw = (LAS unsigned*)(lds + att::UNIT_OFF);
                for (;;) {
                    if (tid == 0) *uw = atomicAdd(ctr, 1u);
                    LDS_WAIT(); __syncthreads();
                    const int unit = __builtin_amdgcn_readfirstlane((int)*uw);
                    __syncthreads();
                    if (unit >= att::NUNITS) break;
                    int tid_u = tid; asm volatile("" : "+v"(tid_u)); const int lane_u = tid_u & 63;
                    if (unit < DB * HEADS) att::attn_unit<false>(unit, lds, (const bf16*)(ws + WS_QB), (const bf16*)(ws + WS_KNOPE), (const bf16*)(ws + WS_KPEB), (const bf16*)(ws + WS_VT), (const float*)(ws + WS_ROPE), CAT, tid_u, wave, lane_u);
                    else att::attn_unit<true>(unit, lds, (const bf16*)(ws + WS_QB), (const bf16*)(ws + WS_KNOPE), (const bf16*)(ws + WS_KPEB), (const bf16*)(ws + WS_VT), (const float*)(ws + WS_ROPE), CAT, tid_u, wave, lane_u);
                }
                }
            }
            END_PHASE;
            if (IN_PHASE) { PH_LOCALS PH_L pg8::Gemm g{CAT, (const bf16*)(ws + WS_WOA) + (size_t)e * D * D, M, D, D, D, D}; pg8::StaticOrder S; S.init(M, D, G, bid);
                pg8::EpiResidNorm E{XN, SSQ + (size_t)(3 * l + 2) * M * 8, D, 1.0f, (PG8_LAS float*)(lds + EPI_P_OFF)}; STAGGER(STAG_RES); pg8::gemm_phase<pg8::EpiResidNorm, pg8::StaticOrder, true, true>(lds + RING_OFF, g, S, E); }
            END_PHASE;
        } else {
            const int o = l >> 1;
            if (IN_PHASE) { PH_LOCALS PH_L pg8::Gemm g{XN, (const bf16*)(ws + WS_WINC) + (size_t)o * DINC * D, M, DINC, D, D, D}; pg8::StaticOrder S; S.init(M, DINC, G, bid);
                pg8::EpiGla E{(bf16*)(ws + WS_ZC), DINC, (const float*)(ws + WS_LB) + o * 2048, SSQ + (size_t)(3 * l + 1) * M * 8}; STAGGER(STAG_IN); pg8::gemm_phase<pg8::EpiGla, pg8::StaticOrder, true, true>(lds + RING_OFF, g, S, E); }
            END_PHASE;
            if (IN_PHASE) { PH_LOCALS PH_L
                for (int rep = 0; rep < REP_GLA; ++rep) {
                unsigned* ctr = (unsigned*)(ws + WS_CTL) + CW_GLA + 64 * o + 1024 * rep;
                LAS unsigned* uw = (LAS unsigned*)(lds + gla::UNIT);
                for (;;) {
                    if (tid == 0) *uw = atomicAdd(ctr, 1u);
                    LDS_WAIT(); __syncthreads();
                    const int unit = __builtin_amdgcn_readfirstlane((int)*uw);
                    __syncthreads();
                    if (unit >= gla::NUNITS) break;
                    gla::gla_unit(unit, lds, (const bf16*)(ws + WS_ZC), args.in[I_SHG] + (size_t)o * DB * HGH * HGD * HGD, args.in[I_GO] + o * HGD, CAT,
                                  X + O_HGP + (size_t)o * NB * HGH * HGD * HGD, X + O_HGS + (size_t)o * DB * HGH * HGD * HGD, tid, wave, lane);
                }
                }
            }
            END_PHASE;
            if (IN_PHASE) { PH_LOCALS PH_L pg8::Gemm g{CAT, (const bf16*)(ws + WS_WOC) + (size_t)o * D * D, M, D, D, D, D}; pg8::StaticOrder S; S.init(M, D, G, bid);
                pg8::EpiResidNorm E{XN, SSQ + (size_t)(3 * l + 2) * M * 8, D, 1.0f, (PG8_LAS float*)(lds + EPI_P_OFF)}; STAGGER(STAG_RES); pg8::gemm_phase<pg8::EpiResidNorm, pg8::StaticOrder, true, true>(lds + RING_OFF, g, S, E); }
            END_PHASE;
        }
        FFN_STEP(1)
    }
#undef FFN_STEP
    if (IN_PHASE) { PH_LOCALS
        const float* gain = args.in[I_NFIN]; const pg8::ssq_t* ssf = SSQ + (size_t)12 * M * 8;
        for (int m = gw; m < M; m += NGW) { const GAS v2u* xr = (const GAS v2u*)(XN + (size_t)m * D) + lane; GAS f32x4* yo = (GAS f32x4*)(X + (size_t)m * D) + lane; const GAS f32x4* gr = (const GAS f32x4*)gain + lane;
            const float rstd = pg8::row_rstd(ssf, m);
#pragma unroll
            for (int j = 0; j < 8; ++j) { const v2u w = xr[64 * j]; const f32x4 g = gr[64 * j]; yo[64 * j] = (f32x4){bflo(w.x) * rstd * g.x, bfhi(w.x) * rstd * g.y, bflo(w.y) * rstd * g.z, bfhi(w.y) * rstd * g.w}; } }
    }
    ++ph;
#undef IN_PHASE
#undef END_PHASE
}

extern "C" void kernel_launch(void* const* d_in, const int* in_sizes, int n_in, void* d_out, int out_size, void* d_ws, size_t ws_size, hipStream_t stream) {
    static int grid = 0;
    if (grid == 0) {
        if (n_in != N_IN || (size_t)out_size != O_END || ws_size < WS_TOTAL) { fprintf(stderr, "kernel_launch: unexpected shapes (n_in %d, out %d, ws %zu); nothing launched\n", n_in, out_size, ws_size); grid = -1; return; }
        int dev = 0, cus = 0, per_cu = 0;
        if (hipGetDevice(&dev) != hipSuccess || hipDeviceGetAttribute(&cus, hipDeviceAttributeMultiprocessorCount, dev) != hipSuccess) { grid = -1; return; }
        if (hipFuncSetAttribute((const void*)mega_fwd, hipFuncAttributeMaxDynamicSharedMemorySize, LDS_BYTES) != hipSuccess) { fprintf(stderr, "kernel_launch: hipFuncSetAttribute failed\n"); grid = -1; return; }
        if (hipOccupancyMaxActiveBlocksPerMultiprocessor(&per_cu, (const void*)mega_fwd, NTHR, LDS_BYTES) != hipSuccess || per_cu < 1) { fprintf(stderr, "kernel_launch: occupancy query says %d\n", per_cu); (void)hipGetLastError(); grid = -1; return; }
        grid = cus;
    }
    if (grid < 0) return;
    if (hipMemsetAsync((char*)d_ws + WS_CTL, 0, CTL_ZERO_BYTES, stream) != hipSuccess) return;
    Args a{};
    for (int i = 0; i < N_IN; ++i) a.in[i] = (const float*)d_in[i];
    a.out = (float*)d_out; a.ws = (unsigned char*)d_ws;
#if MK_ONE_LAUNCH
    a.ph_lo = 0; a.ph_hi = N_PHASES;
    hipLaunchKernelGGL(mega_fwd, dim3(grid), dim3(NTHR), LDS_BYTES, stream, a);
#else
    for (int p = 0; p < N_PHASES; ++p) { a.ph_lo = p; a.ph_hi = p + 1; hipLaunchKernelGGL(mega_fwd, dim3(grid), dim3(NTHR), LDS_BYTES, stream, a); }
#endif
}
```

```cpp
#include <hip/hip_runtime.h>
#include <cstdio>
#include <cstdint>
namespace pg8 {
#define PG8_LAS __attribute__((address_space(3)))
typedef unsigned short bf16_t;
typedef short bf16x8 __attribute__((ext_vector_type(8)));
typedef float f32x4 __attribute__((ext_vector_type(4)));
typedef unsigned u32x4 __attribute__((ext_vector_type(4)));
constexpr int BM = 256, BK = 64, HALF = 128, HTB = HALF * BK * 2  , STAGE_BYTES = 8 * HTB, NXCD = 8, WGM = 8;

__host__ __device__ __forceinline__ int lds_byte(int r, int c) { const int st = (r >> 4) * 2 + (c >> 5), rr = r & 15, cc = c & 31, ob = rr * 64 + cc * 2; return st * 1024 + (ob ^ (((ob >> 9) & 1) << 5)); }
__host__ __device__ __forceinline__ void stage_rc(int b, int& R, int& C) { const int st = b / 1024, sb = b % 1024, swz = sb ^ (((sb >> 9) & 1) << 5); R = (st >> 1) * 16 + swz / 64; C = (st & 1) * 32 + (swz % 64) / 2; }
__host__ __device__ __forceinline__ int perm32(int rho) { const int n = rho >> 4, i = rho & 15; return 8 * (i >> 2) + 4 * n + (i & 3); }

struct Unit { int pm, pn; };
struct Gemm { const bf16_t* A; const bf16_t* Bt; int M, N, K, lda, ldb; };

struct StaticOrder {
    int nM, nN, nwg, G, c, wgm;
    __host__ __device__ void init(int M, int N, int G_, int c_, int wgm_ = 4) { nM = M / BM; nN = N / BM; nwg = nM * nN; G = G_; c = c_; wgm = wgm_; }
    __host__ __device__ bool next(int i, Unit& u) const {
        const long L = (long)i * G + c; if (L >= nwg) return false;
        int wgid = (int)L; { const int q = nwg / NXCD, r = nwg % NXCD, xcd = wgid % NXCD, off = wgid / NXCD; wgid = (xcd < r ? xcd * (q + 1) : r * (q + 1) + (xcd - r) * q) + off; }
        const int nig = wgm * nN, gid = wgid / nig, fm = gid * wgm, gsz = (nM - fm) < wgm ? (nM - fm) : wgm;
        u.pm = fm + ((wgid % nig) % gsz); u.pn = (wgid % nig) / gsz; return true;
    }
    __device__ __forceinline__ void a_ready(const Unit&) const {}
    __device__ __forceinline__ void done(const Unit&) const {}
};

typedef float f32x2_t __attribute__((ext_vector_type(2))); typedef __bf16 bf16x2_t __attribute__((ext_vector_type(2)));
__device__ __forceinline__ unsigned cvt_pk_bf16(float lo, float hi) { const f32x2_t v = {lo, hi}; const bf16x2_t b = __builtin_convertvector(v, bf16x2_t); return __builtin_bit_cast(unsigned, b); }
typedef float f32x2 __attribute__((ext_vector_type(2)));
__device__ __forceinline__ float fast_sigmoid(float x) { return __builtin_amdgcn_rcpf(1.0f + __builtin_amdgcn_exp2f(-1.44269504089f * x)); }
__device__ __forceinline__ float fast_silu(float x) { return x * fast_sigmoid(x); }

typedef float ssq_t;
__device__ __forceinline__ float row_rstd(const ssq_t* ssp, int row) { const f32x4 a = *(const f32x4*)(ssp + (size_t)row * 8), b = *(const f32x4*)(ssp + (size_t)row * 8 + 4);
    return __builtin_amdgcn_rsqf((((a[0] + a[1]) + (a[2] + a[3])) + ((b[0] + b[1]) + (b[2] + b[3]))) * (1.0f / 2048.0f) + 1e-6f); }

struct RsRaw { f32x4 a, b; };
__device__ __forceinline__ RsRaw rs_issue(const ssq_t* ssp, const Unit& u, int wid, int lane) { RsRaw r; const ssq_t* p = ssp + (size_t)(u.pm * BM + wid * 32 + (lane & 31)) * 8; r.a = *(const f32x4*)p; r.b = *(const f32x4*)(p + 4); return r; }
__device__ __forceinline__ void rs_finish(const RsRaw& r, PG8_LAS float* rsbuf, int wid, int lane) { const f32x4 a = r.a, b = r.b;
    const float rs = __builtin_amdgcn_rsqf((((a[0] + a[1]) + (a[2] + a[3])) + ((b[0] + b[1]) + (b[2] + b[3]))) * (1.0f / 2048.0f) + 1e-6f); if (lane < 32) rsbuf[wid * 32 + lane] = rs; }
struct NoRaw {};

struct EpiStore {
    static constexpr bool PERM = true, AFTER_DRAIN = false; static constexpr int NSTORES = 16;
    bf16_t* O; int ldc; const ssq_t* ss;
    typedef RsRaw Raw;
    __device__ __forceinline__ Raw issue(const Unit& u, int wid, int lane) const { if (ss) return rs_issue(ss, u, wid, lane); return Raw{(f32x4){0.f, 0.f, 0.f, 0.f}, (f32x4){0.f, 0.f, 0.f, 0.f}}; }
    __device__ __forceinline__ void finish(const Raw& r, PG8_LAS float* rsbuf, int wid, int lane) const { if (ss) rs_finish(r, rsbuf, wid, lane); }
    __device__ __forceinline__ void operator()(const f32x4 (&acc)[2][2][4][2], const Unit& u, int wr, int wc, int fr, int fq, const PG8_LAS float* rsbuf) const {
        const int row0 = u.pm * BM + wr * 64 + fr, col0 = u.pn * BM + wc * 32 + 8 * fq;
#pragma unroll
        for (int ai = 0; ai < 2; ++ai)
#pragma unroll
            for (int m = 0; m < 4; ++m) { const int row = row0 + ai * HALF + m * 16; bf16_t* rowp = O + (size_t)row * ldc + col0; const float rs = ss ? rsbuf[ai * HALF + wr * 64 + m * 16 + fr] : 1.0f;
#pragma unroll
                for (int bj = 0; bj < 2; ++bj) { const f32x4 v0 = acc[ai][bj][m][0] * rs, v1 = acc[ai][bj][m][1] * rs;
                    u32x4 w; w.x = cvt_pk_bf16(v0[0], v0[1]); w.y = cvt_pk_bf16(v0[2], v0[3]); w.z = cvt_pk_bf16(v1[0], v1[1]); w.w = cvt_pk_bf16(v1[2], v1[3]);
                    *(u32x4*)(rowp + bj * HALF) = w; } }
    }
};
struct EpiSwiGLU {
    static constexpr bool PERM = true, AFTER_DRAIN = false; static constexpr int NSTORES = 8;
    bf16_t* O; int ldc; const ssq_t* ss;
    typedef RsRaw Raw;
    __device__ __forceinline__ Raw issue(const Unit& u, int wid, int lane) const { return rs_issue(ss, u, wid, lane); }
    __device__ __forceinline__ void finish(const Raw& r, PG8_LAS float* rsbuf, int wid, int lane) const { rs_finish(r, rsbuf, wid, lane); }
    __device__ __forceinline__ void operator()(const f32x4 (&acc)[2][2][4][2], const Unit& u, int wr, int wc, int fr, int fq, const PG8_LAS float* rsbuf) const {
        const int row0 = u.pm * BM + wr * 64 + fr, col0 = u.pn * HALF + wc * 32 + 8 * fq;
#pragma unroll
        for (int ai = 0; ai < 2; ++ai)
#pragma unroll
            for (int m = 0; m < 4; ++m) { const int row = row0 + ai * HALF + m * 16; bf16_t* rowp = O + (size_t)row * ldc + col0; const float rs = rsbuf[ai * HALF + wr * 64 + m * 16 + fr];
                const float rsl = rs * -1.44269504089f, rs2 = rs * rs;
                f32x4 h0, h1;
#pragma unroll
                for (int n = 0; n < 2; ++n)
#pragma unroll
                    for (int jj = 0; jj < 2; ++jj) { const f32x2 g = {acc[ai][0][m][n][2 * jj], acc[ai][0][m][n][2 * jj + 1]}, u = {acc[ai][1][m][n][2 * jj], acc[ai][1][m][n][2 * jj + 1]};
                        const f32x2 t = g * rsl; f32x2 e; e.x = __builtin_amdgcn_exp2f(t.x); e.y = __builtin_amdgcn_exp2f(t.y);
                        const f32x2 d = e + 1.0f; f32x2 r; r.x = __builtin_amdgcn_rcpf(d.x); r.y = __builtin_amdgcn_rcpf(d.y);
                        const f32x2 hh = (g * u) * (r * rs2);
                        if (n == 0) { h0[2 * jj] = hh.x; h0[2 * jj + 1] = hh.y; } else { h1[2 * jj] = hh.x; h1[2 * jj + 1] = hh.y; } }
                u32x4 w; w.x = cvt_pk_bf16(h0[0], h0[1]); w.y = cvt_pk_bf16(h0[2], h0[3]); w.z = cvt_pk_bf16(h1[0], h1[1]); w.w = cvt_pk_bf16(h1[2], h1[3]);
                *(u32x4*)rowp = w; }
    }
};
struct EpiResidNorm {
    static constexpr bool PERM = true, AFTER_DRAIN = false; static constexpr int NSTORES = 16;
    bf16_t* XB; ssq_t* ss; int ldc; float scale; PG8_LAS float* P;
    typedef NoRaw Raw;
    __device__ __forceinline__ Raw issue(const Unit&, int, int) const { return Raw{}; }
    __device__ __forceinline__ void finish(const Raw&, PG8_LAS float*, int, int) const {}
    __device__ __forceinline__ void operator()(const f32x4 (&acc)[2][2][4][2], const Unit& u, int wr, int wc, int fr, int fq, const PG8_LAS float*) const {
        const int row0 = u.pm * BM + wr * 64 + fr, col0 = u.pn * BM + wc * 32 + 8 * fq;
#pragma unroll
        for (int ai = 0; ai < 2; ++ai) {
            u32x4 xv[4][2];
#pragma unroll
            for (int m = 0; m < 4; ++m) { const bf16_t* rowp = XB + (size_t)(row0 + ai * HALF + m * 16) * ldc + col0;
#pragma unroll
                for (int bj = 0; bj < 2; ++bj) xv[m][bj] = *(const u32x4*)(rowp + bj * HALF); }
#pragma unroll
            for (int m = 0; m < 4; ++m) { const int row = row0 + ai * HALF + m * 16; bf16_t* rowp = XB + (size_t)row * ldc + col0; float q = 0.f;
#pragma unroll
                for (int bj = 0; bj < 2; ++bj) { const u32x4 x = xv[m][bj];
                    const f32x4 x0 = {__builtin_bit_cast(float, x[0] << 16), __builtin_bit_cast(float, x[0] & 0xffff0000u), __builtin_bit_cast(float, x[1] << 16), __builtin_bit_cast(float, x[1] & 0xffff0000u)};
                    const f32x4 x1 = {__builtin_bit_cast(float, x[2] << 16), __builtin_bit_cast(float, x[2] & 0xffff0000u), __builtin_bit_cast(float, x[3] << 16), __builtin_bit_cast(float, x[3] & 0xffff0000u)};
                    const f32x4 v0 = x0 + acc[ai][bj][m][0] * scale, v1 = x1 + acc[ai][bj][m][1] * scale;
                    q += ((v0[0] * v0[0] + v0[1] * v0[1]) + (v0[2] * v0[2] + v0[3] * v0[3])) + ((v1[0] * v1[0] + v1[1] * v1[1]) + (v1[2] * v1[2] + v1[3] * v1[3]));
                    u32x4 w; w.x = cvt_pk_bf16(v0[0], v0[1]); w.y = cvt_pk_bf16(v0[2], v0[3]); w.z = cvt_pk_bf16(v1[0], v1[1]); w.w = cvt_pk_bf16(v1[2], v1[3]); *(u32x4*)(rowp + bj * HALF) = w; }
                q += __shfl_xor(q, 16); q += __shfl_xor(q, 32); if (fq == 0) P[(ai * HALF + wr * 64 + m * 16 + fr) * 4 + wc] = q; }
            asm volatile("" ::: "memory"); }
        {
            asm volatile("s_waitcnt lgkmcnt(0)" ::: "memory"); __builtin_amdgcn_s_barrier(); asm volatile("" ::: "memory");
            const int lane = fr + 16 * fq, r = (wr * 4 + wc) * 32 + lane;
            if (lane < 32) { const f32x4 p = *(const PG8_LAS f32x4*)(P + r * 4); ss[(size_t)(u.pm * BM + r) * 8 + u.pn] = (p[0] + p[1]) + (p[2] + p[3]); }
        }
    }
};
struct EpiGla {
    static constexpr bool PERM = true, AFTER_DRAIN = false; static constexpr int NSTORES = 16;
    bf16_t* O; int ldc; const float* lb; const ssq_t* ss;
    typedef RsRaw Raw;
    __device__ __forceinline__ Raw issue(const Unit& u, int wid, int lane) const { return rs_issue(ss, u, wid, lane); }
    __device__ __forceinline__ void finish(const Raw& r, PG8_LAS float* rsbuf, int wid, int lane) const { rs_finish(r, rsbuf, wid, lane); }
    __device__ __forceinline__ void operator()(const f32x4 (&acc)[2][2][4][2], const Unit& u, int wr, int wc, int fr, int fq, const PG8_LAS float* rsbuf) const {
        const int row0 = u.pm * BM + wr * 64 + fr, col0 = u.pn * BM + wc * 32 + 8 * fq;
        const int sec = u.pn >> 3;
        f32x4 lbv[2][2];
#pragma unroll
        for (int bj = 0; bj < 2; ++bj)
#pragma unroll
            for (int n = 0; n < 2; ++n) lbv[bj][n] = (sec == 1) ? *(const f32x4*)(lb + (col0 - 2048) + bj * HALF + 4 * n) : (f32x4){0.f, 0.f, 0.f, 0.f};
#pragma unroll
        for (int ai = 0; ai < 2; ++ai)
#pragma unroll
            for (int m = 0; m < 4; ++m) { const int row = row0 + ai * HALF + m * 16; bf16_t* rowp = O + (size_t)row * ldc + col0; const float rs = rsbuf[ai * HALF + wr * 64 + m * 16 + fr];
#pragma unroll
                for (int bj = 0; bj < 2; ++bj) { f32x4 v[2] = {acc[ai][bj][m][0] * rs, acc[ai][bj][m][1] * rs};
                    if (sec == 0 || sec == 3) {
#pragma unroll
                        for (int n = 0; n < 2; ++n)
#pragma unroll
                            for (int j = 0; j < 4; ++j) v[n][j] = fast_silu(v[n][j]);
                    } else if (sec == 1) {
#pragma unroll
                        for (int n = 0; n < 2; ++n)
#pragma unroll
                            for (int j = 0; j < 4; ++j) { const float l = lbv[bj][n][j]; v[n][j] = 0.69314718056f * __builtin_amdgcn_logf(l + (1.0f - l) * fast_sigmoid(v[n][j])); }
                    }
                    u32x4 w; w.x = cvt_pk_bf16(v[0][0], v[0][1]); w.y = cvt_pk_bf16(v[0][2], v[0][3]); w.z = cvt_pk_bf16(v[1][0], v[1][1]); w.w = cvt_pk_bf16(v[1][2], v[1][3]);
                    *(u32x4*)(rowp + bj * HALF) = w; } }
    }
};

template <class Epi, class Sched, bool ALIGN_EPI = false, bool SP2 = false>
__device__ __forceinline__ void gemm_phase(PG8_LAS unsigned char* lds, const Gemm g, const Sched& S, const Epi& E) {
    int tid_ = threadIdx.x; asm volatile("" : "+v"(tid_));
    const int tid = tid_, wid = __builtin_amdgcn_readfirstlane(tid >> 6), lane = tid & 63, wr = wid >> 2, wc = wid & 3, fr = lane & 15, fq = lane >> 4;
    const int K = g.K, nt = K / BK;
    unsigned voffA[2], voffB[2];
#pragma unroll
    for (int i = 0; i < 2; ++i) { int R, C; stage_rc(tid * 16 + i * 8192, R, C); const int Rb = Epi::PERM ? ((R & ~31) + perm32(R & 31)) : R;
        voffA[i] = (unsigned)(R * g.lda + C) * 2u; voffB[i] = (unsigned)(Rb * g.ldb + C) * 2u; }
    const size_t kstep = (size_t)(BK * 2);
    const size_t hstepA = (size_t)HALF * g.lda * 2, hstepB = (size_t)HALF * g.ldb * 2;
    const size_t tstepA = 2 * hstepA, tstepB = 2 * hstepB;
    const unsigned ldsw = (unsigned)wid * 1024u;
    const int aoff = lds_byte(wr * 64 + fr, fq * 8), boff = lds_byte(wc * 32 + fr, fq * 8);
#define PG8_SA(b, h) (((b) * 2 + (h)) * HTB)
#define PG8_SB(b, h) ((4 + (b) * 2 + (h)) * HTB)
#define PG8_STAGE(bufoff, gbase, voff) do { _Pragma("unroll") for (int _i = 0; _i < 2; ++_i) \
        __builtin_amdgcn_global_load_lds((const unsigned*)((const char*)(gbase) + (voff)[_i]), (PG8_LAS unsigned*)(lds + (bufoff) + ldsw + _i * 8192), 16, 0, 0); } while (0)
#define PG8_LDA(dst, b, h) do { _Pragma("unroll") for (int m = 0; m < 4; ++m) _Pragma("unroll") for (int k = 0; k < 2; ++k) dst[m][k] = *(const PG8_LAS bf16x8*)(lds + PG8_SA(b, h) + aoff + m * 2048 + k * 1024); } while (0)
#define PG8_LDB(dst, b, h) do { _Pragma("unroll") for (int n = 0; n < 2; ++n) _Pragma("unroll") for (int k = 0; k < 2; ++k) dst[n][k] = *(const PG8_LAS bf16x8*)(lds + PG8_SB(b, h) + boff + n * 2048 + k * 1024); } while (0)
#define PG8_MMA(ai, bj, At, Bt) do { __builtin_amdgcn_s_setprio(1); _Pragma("unroll") for (int m = 0; m < 4; ++m) _Pragma("unroll") for (int n = 0; n < 2; ++n) _Pragma("unroll") for (int k = 0; k < 2; ++k) \
        acc[ai][bj][m][n] = __builtin_amdgcn_mfma_f32_16x16x32_bf16(Bt[n][k], At[m][k], acc[ai][bj][m][n], 0, 0, 0); __builtin_amdgcn_s_setprio(0); } while (0)
#define PG8_WAIT_V(n) asm volatile("s_waitcnt vmcnt(" #n ")" ::: "memory")
#define PG8_WAIT_L(n) asm volatile("s_waitcnt lgkmcnt(" #n ")" ::: "memory")
#define PG8_BAR __builtin_amdgcn_s_barrier()
#define PG8_SCHED __builtin_amdgcn_sched_barrier(0)
    Unit cur, nxt; int ui = 0;
    if (!S.next(0, cur)) return;
    f32x4 acc[2][2][4][2];
#pragma unroll
    for (int a = 0; a < 2; ++a)
#pragma unroll
        for (int b = 0; b < 2; ++b)
#pragma unroll
            for (int m = 0; m < 4; ++m)
#pragma unroll
                for (int n = 0; n < 2; ++n) acc[a][b][m][n] = (f32x4){0.f, 0.f, 0.f, 0.f};
    bf16x8 At[4][2], B0[2][2], B1[2][2];
    const char* cA = (const char*)g.A + (size_t)cur.pm * tstepA; const char* cB = (const char*)g.Bt + (size_t)cur.pn * tstepB;
    S.a_ready(cur);
    PG8_LAS float* const rs_tab = (PG8_LAS float*)(lds + STAGE_BYTES + 256 + 4096);
    int rs_par = 0; E.finish(E.issue(cur, wid, lane), rs_tab, wid, lane);
    if constexpr (SP2) {
        PG8_STAGE(PG8_SB(0, 0), cB, voffB); PG8_STAGE(PG8_SB(0, 1), cB + hstepB, voffB); PG8_STAGE(PG8_SA(0, 0), cA, voffA); PG8_STAGE(PG8_SA(0, 1), cA + hstepA, voffA);
        if (wr == 1) PG8_BAR;
        PG8_WAIT_V(2); PG8_BAR;
        PG8_STAGE(PG8_SB(1, 0), cB + kstep, voffB); PG8_STAGE(PG8_SA(1, 0), cA + kstep, voffA); PG8_STAGE(PG8_SB(1, 1), cB + hstepB + kstep, voffB);
        PG8_WAIT_V(6); PG8_BAR;
    } else {
        PG8_STAGE(PG8_SB(0, 0), cB, voffB); PG8_STAGE(PG8_SA(0, 0), cA, voffA); PG8_STAGE(PG8_SB(0, 1), cB + hstepB, voffB); PG8_STAGE(PG8_SA(0, 1), cA + hstepA, voffA);
        if (wr == 1) PG8_BAR;
        PG8_WAIT_V(4); PG8_BAR;
        PG8_STAGE(PG8_SB(1, 0), cB + kstep, voffB); PG8_STAGE(PG8_SA(1, 0), cA + kstep, voffA); PG8_STAGE(PG8_SB(1, 1), cB + hstepB + kstep, voffB);
        PG8_WAIT_V(6); PG8_BAR;
    }
    for (;;) {
        const bool has_next = S.next(ui + 1, nxt);
        const char* nA = has_next ? (const char*)g.A + (size_t)nxt.pm * tstepA : cA; const char* nB = has_next ? (const char*)g.Bt + (size_t)nxt.pn * tstepB : cB;
        for (int t = 0; t < nt; t += 2) {
            const bool last = (t == nt - 2);
            const char* a1 = cA + (size_t)(t + 1) * kstep;
            const char* a2 = last ? nA : cA + (size_t)(t + 2) * kstep; const char* b2 = last ? nB : cB + (size_t)(t + 2) * kstep;
            const char* a3 = a2 + kstep; const char* b3 = b2 + kstep;
            if (last && has_next) S.a_ready(nxt);
            if constexpr (SP2) {
            PG8_LDB(B0, 0, 0); PG8_LDB(B1, 0, 1); PG8_SCHED; PG8_LDA(At, 0, 0); PG8_STAGE(PG8_SA(1, 1), a1 + hstepA, voffA);
            PG8_WAIT_V(8); PG8_WAIT_L(0); PG8_BAR; PG8_MMA(0, 0, At, B0); PG8_MMA(0, 1, At, B1); PG8_BAR; PG8_SCHED;
            PG8_LDA(At, 0, 1); PG8_STAGE(PG8_SB(0, 0), b2, voffB); PG8_STAGE(PG8_SB(0, 1), b2 + hstepB, voffB); PG8_STAGE(PG8_SA(0, 0), a2, voffA);
            PG8_WAIT_V(8); PG8_WAIT_L(0); PG8_BAR; PG8_MMA(1, 0, At, B0); PG8_MMA(1, 1, At, B1); PG8_BAR; PG8_SCHED;
            PG8_LDB(B0, 1, 0); PG8_LDB(B1, 1, 1); PG8_SCHED; PG8_LDA(At, 1, 0); PG8_STAGE(PG8_SA(0, 1), a2 + hstepA, voffA);
            PG8_WAIT_V(8); PG8_WAIT_L(0); PG8_BAR; PG8_MMA(0, 0, At, B0); PG8_MMA(0, 1, At, B1); PG8_BAR; PG8_SCHED;
            PG8_LDA(At, 1, 1); PG8_STAGE(PG8_SB(1, 0), b3, voffB); PG8_STAGE(PG8_SB(1, 1), b3 + hstepB, voffB); PG8_STAGE(PG8_SA(1, 0), a3, voffA);
            PG8_WAIT_V(8); PG8_WAIT_L(0); PG8_BAR; PG8_MMA(1, 0, At, B0); PG8_MMA(1, 1, At, B1); PG8_BAR; PG8_SCHED;
            } else {
            PG8_LDB(B0, 0, 0); PG8_SCHED; PG8_LDA(At, 0, 0); PG8_STAGE(PG8_SA(1, 1), a1 + hstepA, voffA);
            PG8_WAIT_L(8); PG8_BAR; PG8_WAIT_L(0); PG8_MMA(0, 0, At, B0); PG8_BAR; PG8_SCHED;
            PG8_LDB(B1, 0, 1); PG8_STAGE(PG8_SB(0, 0), b2, voffB);
            PG8_BAR; PG8_WAIT_L(0); PG8_MMA(0, 1, At, B1); PG8_BAR;
            PG8_LDA(At, 0, 1); PG8_STAGE(PG8_SA(0, 0), a2, voffA);
            PG8_BAR; PG8_WAIT_L(0); PG8_MMA(1, 0, At, B0); PG8_BAR; PG8_SCHED;
            PG8_STAGE(PG8_SB(0, 1), b2 + hstepB, voffB);
            PG8_WAIT_V(6); PG8_BAR; PG8_MMA(1, 1, At, B1); PG8_BAR;
            PG8_LDB(B0, 1, 0); PG8_SCHED; PG8_LDA(At, 1, 0); PG8_STAGE(PG8_SA(0, 1), a2 + hstepA, voffA);
            PG8_WAIT_L(8); PG8_BAR; PG8_WAIT_L(0); PG8_MMA(0, 0, At, B0); PG8_BAR; PG8_SCHED;
            PG8_LDB(B1, 1, 1); PG8_STAGE(PG8_SB(1, 0), b3, voffB);
            PG8_BAR; PG8_WAIT_L(0); PG8_MMA(0, 1, At, B1); PG8_BAR;
            PG8_LDA(At, 1, 1); PG8_STAGE(PG8_SA(1, 0), a3, voffA);
            PG8_BAR; PG8_WAIT_L(0); PG8_MMA(1, 0, At, B0); PG8_BAR; PG8_SCHED;
            PG8_STAGE(PG8_SB(1, 1), b3 + hstepB, voffB);
            PG8_WAIT_V(6); PG8_BAR; PG8_MMA(1, 1, At, B1); PG8_BAR;
            }
        }
        if constexpr (ALIGN_EPI) { if (wr == 0) PG8_BAR; }
        if constexpr (!Epi::AFTER_DRAIN) { typename Epi::Raw raw = E.issue(has_next ? nxt : cur, wid, lane); E(acc, cur, wr, wc, fr, fq, rs_tab + rs_par * 256); rs_par ^= 1; E.finish(raw, rs_tab + rs_par * 256, wid, lane); S.done(cur); }
        if (!has_next) break;
#pragma unroll
        for (int a = 0; a < 2; ++a)
#pragma unroll
            for (int b = 0; b < 2; ++b)
#pragma unroll
                for (int m = 0; m < 4; ++m)
#pragma unroll
                    for (int n = 0; n < 2; ++n) acc[a][b][m][n] = (f32x4){0.f, 0.f, 0.f, 0.f};
        cur = nxt; cA = nA; cB = nB; ++ui;
        if constexpr (ALIGN_EPI) { if (wr == 1) PG8_BAR; }
    }
    PG8_WAIT_V(0);
    if constexpr (!ALIGN_EPI) { if (wr == 0) PG8_BAR; }
    PG8_BAR;
#undef PG8_SA
#undef PG8_SB
#undef PG8_STAGE
#undef PG8_LDA
#undef PG8_LDB
#undef PG8_MMA
#undef PG8_WAIT_V
#undef PG8_WAIT_L
#undef PG8_BAR
#undef PG8_SCHED
}
}
constexpr int D = 2048, DFF = 5632, NB = 16, SEQ = 2048, DB = 8, DSEQ = 64, PAST = 4096, DEPTH = 4;
constexpr int MP = NB * SEQ, MS = DB * DSEQ, M = MP + MS;
constexpr int KVS = PAST + DSEQ;
constexpr int KVROWS = MP + DB * KVS;
constexpr int DCONV = 1024, QL = 512, KVL = 512, ROPE = 64, NOPE = 128, VD = 128, HEADS = 8, QHD = NOPE + ROPE;
constexpr int DINA = 3 * DCONV + QL + KVL + ROPE, DINA_P = 4352, DINC = 8192, HGH = 16, HGD = 128;
constexpr float EPS = 1e-6f;
static_assert(M % 256 == 0 && KVROWS % 256 == 0 && DINA == 4160, "shapes");
constexpr size_t O_YP = 0, O_YS = O_YP + (size_t)MP * D, O_CONVP = O_YS + (size_t)MS * D, O_CKVP = O_CONVP + (size_t)2 * NB * 2 * DCONV, O_KPEP = O_CKVP + (size_t)2 * NB * SEQ * KVL,
                 O_HGP = O_KPEP + (size_t)2 * NB * SEQ * ROPE, O_CONVS = O_HGP + (size_t)2 * NB * HGH * HGD * HGD, O_CKVS = O_CONVS + (size_t)2 * DB * 2 * DCONV,
                 O_KPES = O_CKVS + (size_t)2 * DB * DSEQ * KVL, O_HGS = O_KPES + (size_t)2 * DB * DSEQ * ROPE, O_END = O_HGS + (size_t)2 * DB * HGH * HGD * HGD;
static_assert(O_END == 119177216, "output size");
enum { I_XP = 0, I_XS, I_CCONV, I_CCKV, I_CKPE, I_SHG, I_NF1, I_F1G, I_F1U, I_F1D, I_NMIX, I_WINA, I_WCONV, I_GQ, I_WUQ, I_GKV, I_WUKV, I_WOA, I_WINC, I_LB, I_GO, I_WOC, I_NF2, I_F2G, I_F2U, I_F2D, I_NFIN, N_IN };

constexpr size_t MiB = 1u << 20;
constexpr size_t WS_CTL = 0, CTL_ZERO_BYTES = 1 * MiB;
constexpr size_t WS_ROPE = 4 * MiB;
constexpr size_t WS_LB = 5 * MiB + 512 * 1024;
constexpr size_t WS_WGU = 6 * MiB;
constexpr size_t WS_WD = WS_WGU + 8 * 44 * MiB;
constexpr size_t WS_WINA = WS_WD + 8 * 22 * MiB;
constexpr size_t WS_WINC = WS_WINA + 2 * 17 * MiB;
constexpr size_t WS_WUQ = WS_WINC + 2 * 32 * MiB;
constexpr size_t WS_WUKV = WS_WUQ + 3 * MiB;
constexpr size_t WS_WOA = WS_WUKV + 4 * MiB;
constexpr size_t WS_WOC = WS_WOA + 16 * MiB;
constexpr size_t WS_XN = WS_WOC + 16 * MiB;
constexpr size_t WS_CAT = WS_XN + 130 * MiB;
constexpr size_t WS_BIG = WS_CAT + 130 * MiB;
constexpr size_t WS_H = WS_BIG;
constexpr size_t WS_ZC = WS_BIG;
constexpr size_t WS_CQN = WS_BIG;
constexpr size_t WS_KVIN = WS_BIG + 33 * MiB;
constexpr size_t WS_KPEB = WS_BIG + 98 * MiB;
constexpr size_t WS_ZA = WS_BIG + 107 * MiB;
constexpr size_t WS_QB = WS_BIG + 107 * MiB;
constexpr size_t WS_KNOPE = WS_BIG + 205 * MiB;
constexpr size_t WS_VT = WS_BIG + 384 * MiB;
constexpr size_t WS_END = WS_BIG + 520 * MiB;
constexpr size_t WS_SS = WS_END;
constexpr size_t WS_SS_BYTES = (size_t)13 * M * 8 * 4, WS_TOTAL = WS_END + 14 * MiB;
static_assert(WS_END + WS_SS_BYTES <= WS_TOTAL, "ss map");
static_assert(WS_ZA + (size_t)M * DINA_P * 2 <= WS_VT && WS_KNOPE + (size_t)KVROWS * 1024 * 2 <= WS_VT && WS_QB + (size_t)M * 1536 * 2 <= WS_KNOPE && WS_VT + (size_t)1024 * KVROWS * 2 <= WS_END, "even-layer map");
static_assert(WS_CQN + (size_t)M * 512 * 2 <= WS_KVIN && WS_KVIN + (size_t)KVROWS * 512 * 2 <= WS_KPEB && WS_KPEB + (size_t)KVROWS * 64 * 2 <= WS_ZA, "even-layer map 2");
static_assert(WS_ZC + (size_t)M * DINC * 2 <= WS_END && WS_H + (size_t)M * DFF * 2 <= WS_END, "odd/ffn map");
static_assert(WS_ROPE + (size_t)KVS * 64 * 4 <= WS_LB && WS_LB + 2 * 2048 * 4 <= WS_WGU, "ctl map");
constexpr int CW_BAR = 4096;
constexpr int CW_ATTN = 8192;
constexpr int CW_GLA = 8192 + 256;
constexpr int CW_CONV = 8192 + 512;

constexpr int RING_OFF = 0, RING_BYTES = 131072;
constexpr int MISC_OFF = RING_BYTES;
constexpr int EPI_P_OFF = RING_BYTES + 256;
constexpr int LDS_BYTES = 147456;
constexpr int NWAVES = 8, NTHR = 512;

#define GAS __attribute__((address_space(1)))
#define CAS __attribute__((address_space(4)))
#define LAS __attribute__((address_space(3)))
typedef unsigned short bf16;
typedef unsigned v4u __attribute__((ext_vector_type(4)));
typedef unsigned v2u __attribute__((ext_vector_type(2)));
typedef float f32x4 __attribute__((ext_vector_type(4)));
typedef short bf16x8 __attribute__((ext_vector_type(8)));
#define LDS_WAIT() asm volatile("s_waitcnt lgkmcnt(0)" ::: "memory")
#define VM_WAIT() asm volatile("s_waitcnt vmcnt(0)" ::: "memory")
__device__ __forceinline__ unsigned f2bf(float f) { unsigned u = __builtin_bit_cast(unsigned, f); return (u + 0x7fffu + ((u >> 16) & 1u)) >> 16; }
__device__ __forceinline__ unsigned pk2(float lo, float hi) { return f2bf(lo) | (f2bf(hi) << 16); }
__device__ __forceinline__ float bf2f(unsigned b) { return __builtin_bit_cast(float, b << 16); }
__device__ __forceinline__ float bflo(unsigned w) { return __builtin_bit_cast(float, w << 16); }
__device__ __forceinline__ float bfhi(unsigned w) { return __builtin_bit_cast(float, w & 0xffff0000u); }
__device__ __forceinline__ float wave_sum(float v) {
#pragma unroll
    for (int o = 1; o < 64; o <<= 1) v += __shfl_xor(v, o);
    return v;
}
#define XB_TMO      128
#define XB_XCNT(j)  (256  + 64 * (j))
#define XB_XSUB(j)  (1280 + 64 * (j))
#define XB_XGEN(j)  (2304 + 64 * (j))
#define XB_TOP      3328
#define XB_TOPGEN   3392
#define XCD_BAR_WORDS 3456
#define XB_SPIN_CAP (1u << 18)

__device__ __forceinline__ unsigned xb_ld(unsigned* p)              { return __hip_atomic_load(p, __ATOMIC_RELAXED, __HIP_MEMORY_SCOPE_AGENT); }
__device__ __forceinline__ unsigned xb_add(unsigned* p, unsigned v) { return __hip_atomic_fetch_add(p, v, __ATOMIC_RELAXED, __HIP_MEMORY_SCOPE_AGENT); }
__device__ __forceinline__ unsigned xb_xcc_id() { return (unsigned)__builtin_amdgcn_s_getreg((3 << 11) | 20) & 0xFu; }
#define XB_SPIN(cond, bar) do { unsigned _sp = 0; while (cond) { __builtin_amdgcn_s_sleep(1); \
    if ((++_sp & 255u) == 0u) { if (xb_ld(&(bar)[XB_TMO])) break; if (_sp > XB_SPIN_CAP) { atomicAdd(&(bar)[XB_TMO], 1u); break; } } } } while (0)

struct XcdBarrier {
    unsigned* bar; unsigned x;
    volatile LAS unsigned* st;
};

__device__ __forceinline__ XcdBarrier xcd_barrier_post(unsigned* bar, volatile LAS unsigned* st) {
    XcdBarrier b; b.bar = bar; b.x = xb_xcc_id(); b.st = st;
    if (threadIdx.x == 0) (void)xb_add(&bar[XB_XCNT(b.x)], 1u);
    return b;
}
__device__ __forceinline__ void xcd_barrier_complete(unsigned* bar, unsigned x, unsigned& nloc, unsigned& nx) {
    const unsigned G = gridDim.x * gridDim.y * gridDim.z;
    unsigned sum, cnt, mine, sp = 0u;
    for (;;) {
        sum = 0u; cnt = 0u; mine = 0u;
#pragma unroll
        for (unsigned j = 0; j < 16; ++j) { const unsigned c = xb_ld(&bar[XB_XCNT(j)]); sum += c; cnt += (c > 0u) ? 1u : 0u; mine = (j == x) ? c : mine; }
        if (sum == G) break;
        __builtin_amdgcn_s_sleep(1);
        if ((++sp & 255u) == 0u) { if (xb_ld(&bar[XB_TMO])) break; if (sp > XB_SPIN_CAP) { atomicAdd(&bar[XB_TMO], 1u); break; } }
    }
    nloc = mine > 0u ? mine : 1u; nx = cnt > 0u ? cnt : 1u;
}

__device__ __forceinline__ void xcd_barrier(const XcdBarrier& b) {
    asm volatile("s_waitcnt vmcnt(0)" ::: "memory");
    __syncthreads();
    if (threadIdx.x == 0) {
        unsigned* bar = b.bar;
        __builtin_amdgcn_s_waitcnt(0);
        unsigned nloc = b.st[0], nx = b.st[1];
        if (nloc == 0u) { xcd_barrier_complete(bar, b.x, nloc, nx); b.st[0] = nloc; b.st[1] = nx; }
        const unsigned old = xb_add(&bar[XB_XSUB(b.x)], 1u);
        const unsigned gen = old / nloc;
        if (old + 1u == (gen + 1u) * nloc) {
            __builtin_amdgcn_fence(__ATOMIC_RELEASE, "agent");
            asm volatile("s_waitcnt vmcnt(0)" ::: "memory");
            const unsigned og = xb_add(&bar[XB_TOP], 1u);
            const unsigned tg = og / nx;
            if (og + 1u == (tg + 1u) * nx) xb_add(&bar[XB_TOPGEN], 1u);
            else XB_SPIN(xb_ld(&bar[XB_TOPGEN]) == tg, bar);
            __builtin_amdgcn_fence(__ATOMIC_ACQUIRE, "agent");
            xb_add(&bar[XB_XGEN(b.x)], 1u);
            asm volatile("s_waitcnt vmcnt(0)" ::: "memory");
        } else {
            XB_SPIN(xb_ld(&bar[XB_XGEN(b.x)]) == gen, bar);
            __builtin_amdgcn_fence(__ATOMIC_ACQUIRE, "agent");
            asm volatile("s_waitcnt vmcnt(0)" ::: "memory");
        }
    }
    __syncthreads();
}


struct Args { const float* in[N_IN]; float* out; unsigned char* ws; int ph_lo, ph_hi; };
static_assert(sizeof(Args) == (N_IN + 2) * 8 + 8, "Args has no padding");

constexpr int CV_ROWP = 144;
__device__ __forceinline__ void cv_tile(const float* W, int N, bf16* WT, int ldt, int dst_row0, LAS unsigned char* scr, int k0, int n0, int lane, const float* gain) {
    const int c4 = lane & 15, kq = lane >> 4;
#pragma unroll 4
    for (int i = 0; i < 16; ++i) { const int kk = 4 * i + kq; const f32x4 v = *(const GAS f32x4*)(W + (size_t)(k0 + kk) * N + n0 + 4 * c4); const float gk = gain ? gain[k0 + kk] : 1.0f;
        LAS unsigned char* p = scr + (4 * c4) * CV_ROWP + kk * 2;
        *(LAS unsigned short*)(p) = (unsigned short)f2bf(v.x * gk); *(LAS unsigned short*)(p + CV_ROWP) = (unsigned short)f2bf(v.y * gk);
        *(LAS unsigned short*)(p + 2 * CV_ROWP) = (unsigned short)f2bf(v.z * gk); *(LAS unsigned short*)(p + 3 * CV_ROWP) = (unsigned short)f2bf(v.w * gk); }
    LDS_WAIT(); asm volatile("" ::: "memory");
    const int c = lane & 7, nr = lane >> 3;
#pragma unroll
    for (int j = 0; j < 8; ++j) { const int n = nr + 8 * j; const v4u o = *(const LAS v4u*)(scr + n * CV_ROWP + c * 16);
        *(GAS v4u*)(WT + (size_t)(dst_row0 + n) * ldt + k0 + 8 * c) = o; }
    LDS_WAIT(); asm volatile("" ::: "memory");
}
constexpr int CV_FFN = 2816, CV_INA = 32 * 65, CV_INC = 32 * 128, CV_UQ = 8 * 24, CV_UKV = 8 * 32, CV_O = 32 * 32;
__device__ __forceinline__ void cv_ffn_item(const float* const CAS* in, unsigned char* ws, int f, int l, int r, LAS unsigned char* scr, int lane) {
    const int type = r / CV_FFN, item = r % CV_FFN, inst = f * 4 + l;
    if (type < 2) { const float* src = in[f ? (type ? I_F2U : I_F2G) : (type ? I_F1U : I_F1G)] + (size_t)l * D * DFF; const int kb = item / 88, nb = item % 88, n0 = 64 * nb;
        cv_tile(src, DFF, (bf16*)(ws + WS_WGU) + (size_t)inst * 2 * DFF * D, D, 256 * (n0 >> 7) + (n0 & 127) + (type ? 128 : 0), scr, 64 * kb, n0, lane, in[f ? I_NF2 : I_NF1] + l * D); }
    else { const float* src = in[f ? I_F2D : I_F1D] + (size_t)l * DFF * D; const int kb = item >> 5, nb = item & 31;
        cv_tile(src, D, (bf16*)(ws + WS_WD) + (size_t)inst * D * DFF, DFF, 64 * nb, scr, 64 * kb, 64 * nb, lane, nullptr); }
}
__device__ __forceinline__ int cv_group_items(int g) { if (g == 0 || (g & 1) == 0) return 3 * CV_FFN; const int l = (g - 1) >> 1; return ((l & 1) ? CV_INC + CV_O : CV_INA + CV_UQ + CV_UKV + CV_O) + 3 * CV_FFN; }
__device__ __forceinline__ void cv_group_item(const float* const CAS* in, unsigned char* ws, int g, int r, LAS unsigned char* scr, int lane) {
    if (g == 0) { cv_ffn_item(in, ws, 0, 0, r, scr, lane); return; }
    if ((g & 1) == 0) { cv_ffn_item(in, ws, 0, g >> 1, r, scr, lane); return; }
    const int l = (g - 1) >> 1, e = l >> 1;
    if (l & 1) {
        if (r < CV_INC) { const int kb = r >> 7, nb = r & 127; cv_tile(in[I_WINC] + (size_t)e * D * DINC, DINC, (bf16*)(ws + WS_WINC) + (size_t)e * DINC * D, D, 64 * nb, scr, 64 * kb, 64 * nb, lane, in[I_NMIX] + l * D); return; } r -= CV_INC;
        if (r < CV_O) { const int kb = r >> 5, nb = r & 31; cv_tile(in[I_WOC] + (size_t)e * D * D, D, (bf16*)(ws + WS_WOC) + (size_t)e * D * D, D, 64 * nb, scr, 64 * kb, 64 * nb, lane, nullptr); return; } r -= CV_O;
    } else {
        if (r < CV_INA) { const int kb = r / 65, nb = r % 65; cv_tile(in[I_WINA] + (size_t)e * D * DINA, DINA, (bf16*)(ws + WS_WINA) + (size_t)e * DINA_P * D, D, 64 * nb, scr, 64 * kb, 64 * nb, lane, in[I_NMIX] + l * D); return; } r -= CV_INA;
        if (r < CV_UQ) { const int kb = r / 24, nb = r % 24; cv_tile(in[I_WUQ] + (size_t)e * QL * 1536, 1536, (bf16*)(ws + WS_WUQ) + (size_t)e * 1536 * QL, QL, 64 * nb, scr, 64 * kb, 64 * nb, lane, nullptr); return; } r -= CV_UQ;
        if (r < CV_UKV) { const int kb = r >> 5, nb = r & 31, n0 = 64 * nb, hh = n0 >> 8, rr = n0 & 255;
            cv_tile(in[I_WUKV] + (size_t)e * KVL * 2048, 2048, (bf16*)(ws + WS_WUKV) + (size_t)e * 2048 * KVL, KVL, (rr < 128 ? 0 : 1024) + hh * 128 + (rr & 127), scr, 64 * kb, n0, lane, nullptr); return; } r -= CV_UKV;
        if (r < CV_O) { const int kb = r >> 5, nb = r & 31; cv_tile(in[I_WOA] + (size_t)e * D * D, D, (bf16*)(ws + WS_WOA) + (size_t)e * D * D, D, 64 * nb, scr, 64 * kb, 64 * nb, lane, nullptr); return; } r -= CV_O;
    }
    cv_ffn_item(in, ws, 1, l, r, scr, lane);
}
__device__ __forceinline__ void cv_group(const float* const CAS* in, unsigned char* ws, int g, unsigned* ctr, LAS unsigned char* scr, int lane, int part = 0) {
    const int nall = cv_group_items(g), lo = part == 2 ? nall - 2 * CV_FFN : 0, n = part == 1 ? nall - 2 * CV_FFN : nall;
    for (;;) { unsigned base = 0; if (lane == 0) base = atomicAdd(ctr, 4u); base = (unsigned)__builtin_amdgcn_readfirstlane((int)base); const int b0 = lo + (int)base;
        if (b0 >= n) break;
        for (int j = 0; j < 4; ++j) if (b0 + j < n) cv_group_item(in, ws, g, b0 + j, scr, lane); }
}
__device__ __forceinline__ void x_row_init(const float* xin, bf16* brow, pg8::ssq_t* ss, int lane) {
    const GAS f32x4* xr = (const GAS f32x4*)xin + lane; GAS v2u* o8 = (GAS v2u*)brow + lane;
    float s = 0.f;
#pragma unroll
    for (int j = 0; j < 8; ++j) { const f32x4 v = xr[64 * j]; s += (v.x * v.x + v.y * v.y) + (v.z * v.z + v.w * v.w); v2u w; w.x = pk2(v.x, v.y); w.y = pk2(v.z, v.w); o8[64 * j] = w; }
    s = wave_sum(s);
    if (lane < 8) ss[lane] = lane == 0 ? s : 0.f;
}

namespace att {
constexpr int KROW = 400, VROW = 144;
constexpr int KBYTES = 64 * KROW, VBYTES = 128 * VROW, BUF = KBYTES + VBYTES;
constexpr int UNIT_OFF = 2 * BUF;
constexpr int NUNITS = DB * HEADS + NB * HEADS * 8;
constexpr float SC_LOG2E = 0.07216878364870322f * 1.44269504088896f;
static_assert(UNIT_OFF + 64 <= RING_BYTES, "attention LDS");

struct Stage { v4u kn[2]; v4u kp; v4u vt[2]; };

__device__ __forceinline__ void stage_load(Stage& s, const bf16* KN, const bf16* KP, const bf16* VTp, int kvrow, int h, int tid) {
    const GAS bf16* kn = (const GAS bf16*)(KN + (size_t)kvrow * 1024 + h * 128); const GAS bf16* kp = (const GAS bf16*)(KP + (size_t)kvrow * 64); const GAS bf16* vt = (const GAS bf16*)(VTp + (size_t)h * 128 * KVROWS + kvrow);
#pragma unroll
    for (int i = 0; i < 2; ++i) { const unsigned p = tid + 512 * i, off = (p >> 4) * 1024u + 8u * (p & 15); s.kn[i] = *(const GAS v4u*)(kn + off); }
    { const unsigned off = (unsigned)(tid >> 3) * 64u + 8u * (tid & 7); s.kp = *(const GAS v4u*)(kp + off); }
#pragma unroll
    for (int i = 0; i < 2; ++i) { const unsigned p = tid + 512 * i, off = (p >> 3) * (unsigned)KVROWS + 8u * (p & 7); s.vt[i] = *(const GAS v4u*)(vt + off); }
}
__device__ __forceinline__ void stage_store(const Stage& s, LAS unsigned char* buf, int tid) {
#pragma unroll
    for (int i = 0; i < 2; ++i) { const int p = tid + 512 * i, key = p >> 4, c = p & 15; *(LAS v4u*)(buf + key * KROW + c * 16) = s.kn[i]; }
    { const int key = tid >> 3, c = tid & 7; *(LAS v4u*)(buf + key * KROW + 256 + c * 16) = s.kp; }
#pragma unroll
    for (int i = 0; i < 2; ++i) { const int p = tid + 512 * i, dv = p >> 3, c = p & 7; *(LAS v4u*)(buf + KBYTES + dv * VROW + c * 16) = s.vt[i]; }
}

template <bool two>
__device__ __forceinline__ void attn_unit(int unit, LAS unsigned char* lds, const bf16* QB, const bf16* KN, const bf16* KP, const bf16* VTp, const float* rope, bf16* CAT, int tid, int wave, int lane) {
    const int fr = lane & 15, fq = lane >> 4;
    int h, qrow0, kvrow0, ntiles, wlimit, pos0; bool active;
    if constexpr (!two) { const int b = unit >> 3; h = unit & 7; qrow0 = MP + b * DSEQ; kvrow0 = MP + b * KVS; ntiles = KVS / 64; wlimit = ntiles; pos0 = PAST; active = wave < 4; }
    else { const int v = unit - DB * HEADS, qt = 7 - (v >> 7), bh = v & 127, b = bh >> 3; h = bh & 7; qrow0 = b * SEQ + 256 * qt; kvrow0 = b * SEQ; ntiles = 4 * qt + 4; wlimit = 4 * qt + (wave >> 1) + 1; pos0 = 256 * qt; active = true; }
    constexpr int rpw = two ? 32 : 16;
    bf16x8 q[2][6];
#pragma unroll
    for (int ks = 0; ks < 6; ++ks) q[1][ks] = (bf16x8){0, 0, 0, 0, 0, 0, 0, 0};
    if (active) {
#pragma unroll
        for (int rg = 0; rg < (two ? 2 : 1); ++rg) { const int rr = rpw * wave + 16 * rg + fr; const bf16* qp = QB + (size_t)(qrow0 + rr) * 1536 + h * QHD + 8 * fq;
#pragma unroll
            for (int ks = 0; ks < 6; ++ks) q[rg][ks] = *(const GAS bf16x8*)(qp + 32 * ks);
            const float* rp = rope + (size_t)(pos0 + rr) * 64 + 16 * fq;
#pragma unroll
            for (int j = 0; j < 8; ++j) { const float c = rp[2 * j], s = rp[2 * j + 1]; const float x1 = bf2f((unsigned short)q[rg][4][j]), x2 = bf2f((unsigned short)q[rg][5][j]);
                q[rg][4][j] = (short)f2bf(x1 * c - x2 * s); q[rg][5][j] = (short)f2bf(x1 * s + x2 * c); } }
    } else {
#pragma unroll
        for (int rg = 0; rg < 2; ++rg)
#pragma unroll
            for (int ks = 0; ks < 6; ++ks) q[rg][ks] = (bf16x8){0, 0, 0, 0, 0, 0, 0, 0};
    }
    f32x4 o[2][8]; float mrow[2], lrow[2];
#pragma unroll
    for (int rg = 0; rg < 2; ++rg) { mrow[rg] = -1e30f; lrow[rg] = 0.f;
#pragma unroll
        for (int n = 0; n < 8; ++n) o[rg][n] = (f32x4){0.f, 0.f, 0.f, 0.f}; }
    Stage st;
    stage_load(st, KN, KP, VTp, kvrow0, h, tid);
    stage_store(st, lds, tid);
    LDS_WAIT(); __syncthreads();
    for (int kt = 0; kt < ntiles; ++kt) {
        LAS unsigned char* cur = lds + (kt & 1) * BUF; LAS unsigned char* nxt = lds + ((kt + 1) & 1) * BUF;
        const bool more = kt + 1 < ntiles;
        if (more) stage_load(st, KN, KP, VTp, kvrow0 + 64 * (kt + 1), h, tid);
        if (active && kt < wlimit) {
            f32x4 s[2][4];
#pragma unroll
            for (int rg = 0; rg < 2; ++rg)
#pragma unroll
                for (int kk = 0; kk < 4; ++kk) s[rg][kk] = (f32x4){0.f, 0.f, 0.f, 0.f};
#pragma unroll
            for (int ks = 0; ks < 6; ++ks) {
                bf16x8 kf[4];
#pragma unroll
                for (int kk = 0; kk < 4; ++kk) kf[kk] = *(const LAS bf16x8*)(cur + (16 * kk + fr) * KROW + ks * 64 + fq * 16);
#pragma unroll
                for (int kk = 0; kk < 4; ++kk) {
                    s[0][kk] = __builtin_amdgcn_mfma_f32_16x16x32_bf16(kf[kk], q[0][ks], s[0][kk], 0, 0, 0);
                    if constexpr (two) s[1][kk] = __builtin_amdgcn_mfma_f32_16x16x32_bf16(kf[kk], q[1][ks], s[1][kk], 0, 0, 0); }
            }
            bf16x8 pb[2][2];
#pragma unroll
            for (int rg = 0; rg < (two ? 2 : 1); ++rg) {
                float mx = -1e30f;
#pragma unroll
                for (int kk = 0; kk < 4; ++kk) { s[rg][kk] = s[rg][kk] * SC_LOG2E; mx = fmaxf(mx, fmaxf(fmaxf(s[rg][kk][0], s[rg][kk][1]), fmaxf(s[rg][kk][2], s[rg][kk][3]))); }
                mx = fmaxf(mx, __shfl_xor(mx, 16)); mx = fmaxf(mx, __shfl_xor(mx, 32));
                const float mnew = fmaxf(mrow[rg], mx), alpha = __builtin_amdgcn_exp2f(mrow[rg] - mnew); mrow[rg] = mnew;
                float ps = 0.f;
#pragma unroll
                for (int kk = 0; kk < 4; ++kk)
#pragma unroll
                    for (int j = 0; j < 4; ++j) { const float p = __builtin_amdgcn_exp2f(s[rg][kk][j] - mnew); s[rg][kk][j] = p; ps += p; }
                lrow[rg] = lrow[rg] * alpha + ps;
#pragma unroll
                for (int n = 0; n < 8; ++n) o[rg][n] = o[rg][n] * alpha;
#pragma unroll
                for (int k2 = 0; k2 < 2; ++k2) { v4u w; w.x = pg8::cvt_pk_bf16(s[rg][2 * k2][0], s[rg][2 * k2][1]); w.y = pg8::cvt_pk_bf16(s[rg][2 * k2][2], s[rg][2 * k2][3]);
                    w.z = pg8::cvt_pk_bf16(s[rg][2 * k2 + 1][0], s[rg][2 * k2 + 1][1]); w.w = pg8::cvt_pk_bf16(s[rg][2 * k2 + 1][2], s[rg][2 * k2 + 1][3]); pb[rg][k2] = __builtin_bit_cast(bf16x8, w); }
            }
            if constexpr (!two) { pb[1][0] = (bf16x8){0, 0, 0, 0, 0, 0, 0, 0}; pb[1][1] = (bf16x8){0, 0, 0, 0, 0, 0, 0, 0}; }
            const LAS unsigned char* vb = cur + KBYTES;
#pragma unroll
            for (int n = 0; n < 8; ++n) {
                v2u vr[2][2];
#pragma unroll
                for (int k2 = 0; k2 < 2; ++k2) { const LAS unsigned char* vp = vb + (16 * n + fr) * VROW + k2 * 64 + fq * 8; vr[k2][0] = *(const LAS v2u*)vp; vr[k2][1] = *(const LAS v2u*)(vp + 32); }
#pragma unroll
                for (int k2 = 0; k2 < 2; ++k2) { const v4u w = {vr[k2][0].x, vr[k2][0].y, vr[k2][1].x, vr[k2][1].y}; const bf16x8 vf = __builtin_bit_cast(bf16x8, w);
                    o[0][n] = __builtin_amdgcn_mfma_f32_16x16x32_bf16(vf, pb[0][k2], o[0][n], 0, 0, 0);
                    if constexpr (two) o[1][n] = __builtin_amdgcn_mfma_f32_16x16x32_bf16(vf, pb[1][k2], o[1][n], 0, 0, 0); }
            }
        }
        if (more) stage_store(st, nxt, tid);
        LDS_WAIT(); __syncthreads();
    }
    if (active) {
#pragma unroll
        for (int rg = 0; rg < (two ? 2 : 1); ++rg) { float l = lrow[rg]; l += __shfl_xor(l, 16); l += __shfl_xor(l, 32); const float inv = 1.0f / l;
            bf16* op = CAT + (size_t)(qrow0 + rpw * wave + 16 * rg + fr) * D + DCONV + h * VD + 4 * fq;
#pragma unroll
            for (int n = 0; n < 8; ++n) { v2u w; w.x = pg8::cvt_pk_bf16(o[rg][n][0] * inv, o[rg][n][1] * inv); w.y = pg8::cvt_pk_bf16(o[rg][n][2] * inv, o[rg][n][3] * inv); *(GAS v2u*)(op + 16 * n) = w; } }
    }
}
}

namespace gla {
#define WG_SYNC() do { asm volatile("s_waitcnt lgkmcnt(0)" ::: "memory"); __builtin_amdgcn_s_barrier(); asm volatile("" ::: "memory"); } while (0)
constexpr int ROWD = 272, ROWT = 144;
constexpr int KEND = 0, QT = KEND + 64 * ROWD, QJ = QT + 64 * ROWD, KLT = QJ + 160 * ROWD, VT = KLT + 128 * ROWT, SC = VT + 128 * ROWT, TOT = SC + 64 * ROWT, EAL = TOT + 2048, SSQ = EAL + 512, UNIT = SSQ + 2048, END = UNIT + 64;
static_assert(END <= RING_BYTES, "gla LDS");
constexpr int NUNITS = NB * HGH + DB * HGH;

__device__ __forceinline__ void load_raw(unsigned (&rq)[16], unsigned (&rg)[16], unsigned (&rv)[16], const bf16* zrow, int d) {
#pragma unroll
    for (int r = 0; r < 16; ++r) { const GAS bf16* p = (const GAS bf16*)(zrow + (size_t)r * DINC + d); rq[r] = p[0]; rg[r] = p[2048]; rv[r] = p[4096]; }
}

__device__ __forceinline__ void gla_unit(int unit, LAS unsigned char* lds, const bf16* ZC, const float* S0all  , const float* g_o, bf16* OB, float* hg_p  , float* hg_s  , int tid, int wave, int lane) {
    const int fr = lane & 15, fq = lane >> 4, d = tid & 127, sb = tid >> 7;
    const bool smp = unit >= NB * HGH;
    const int u2 = smp ? unit - NB * HGH : unit, b = u2 >> 4, h = u2 & 15;
    const int nch = smp ? 1 : SEQ / 64, row0 = smp ? MP + b * DSEQ : b * SEQ;
    float* sout = smp ? hg_s + ((size_t)(b * HGH + h) << 14) : hg_p + ((size_t)(b * HGH + h) << 14);
    f32x4 S[8];
    if (smp) { const float* s0 = S0all + ((size_t)(b * HGH + h) << 14) + 16 * wave + fr;
#pragma unroll
        for (int a = 0; a < 8; ++a)
#pragma unroll
            for (int e = 0; e < 4; ++e) S[a][e] = s0[(16 * a + 4 * fq + e) * 128]; }
    else {
#pragma unroll
        for (int a = 0; a < 8; ++a) S[a] = (f32x4){0.f, 0.f, 0.f, 0.f}; }
    float gov[4];
#pragma unroll
    for (int e = 0; e < 4; ++e) gov[e] = g_o[16 * wave + 4 * fq + e];
    unsigned rq[16], rg[16], rv[16];
    load_raw(rq, rg, rv, ZC + (size_t)(row0 + 16 * sb) * DINC + h * 128, d);
    LAS float* tot = (LAS float*)(lds + TOT); LAS float* eal = (LAS float*)(lds + EAL); LAS float* ssq = (LAS float*)(lds + SSQ);
    for (int c = 0; c < nch; ++c) {
        float fx[16], e1[16], bk[16];
        { float run = 0.f;
#pragma unroll
          for (int r = 0; r < 16; ++r) { const float g = bf2f(rg[r]); run += g; fx[r] = __builtin_amdgcn_exp2f(g * 1.44269504089f); }
          tot[sb * 128 + d] = run; }
        e1[0] = fx[0]; bk[15] = 1.0f;
#pragma unroll
        for (int r = 1; r < 16; ++r) { e1[r] = e1[r - 1] * fx[r]; bk[15 - r] = bk[16 - r] * fx[16 - r]; }
        WG_SYNC();
        float P[5]; P[0] = 0.f;
#pragma unroll
        for (int j = 0; j < 4; ++j) P[j + 1] = P[j] + tot[j * 128 + d];
        float Pi = 0.f, Pi1 = 0.f;
#pragma unroll
        for (int j = 0; j < 4; ++j) if (j == sb) { Pi = P[j]; Pi1 = P[j + 1]; }
        const float alast = P[4];
        const float e_tail = __expf(alast - Pi1);
        const float e_head = __expf(Pi);
        float Fj[3];
#pragma unroll
        for (int j = 0; j < 3; ++j) Fj[j] = __expf(Pi - P[j + 1]);
        if (sb == 0) eal[d] = __expf(alast);
        unsigned klt[8], vtt[8];
        LAS unsigned char* const kend_p = lds + KEND + (16 * sb) * ROWD + d * 2;
        LAS unsigned char* const qt_p = lds + QT + (16 * sb) * ROWD + d * 2;
#pragma unroll
        for (int r = 0; r < 16; r += 2) {
            float kl[2];
#pragma unroll
            for (int h2 = 0; h2 < 2; ++h2) { const int rr = r + h2;
                const float qv = bf2f(rq[rr]), kend = (1.0f - fx[rr]) * bk[rr], qe = qv * e1[rr];
                kl[h2] = kend * e_tail;
                const unsigned w = pg8::cvt_pk_bf16(kend, qe * e_head);
                *(LAS unsigned short*)(kend_p + rr * ROWD) = (unsigned short)w; *(LAS unsigned short*)(qt_p + rr * ROWD) = (unsigned short)(w >> 16);
                const float qd = qv * __builtin_amdgcn_rcpf(fmaxf(bk[rr], 1e-30f));
                if (sb == 0) { *(LAS unsigned short*)(lds + QJ + (0 + rr) * ROWD + d * 2) = (unsigned short)pg8::cvt_pk_bf16(qd, 0.f); }
                else if (sb == 1) { const unsigned u = pg8::cvt_pk_bf16(qe * Fj[0], qd);
                    *(LAS unsigned short*)(lds + QJ + (16 + rr) * ROWD + d * 2) = (unsigned short)u; *(LAS unsigned short*)(lds + QJ + (64 + rr) * ROWD + d * 2) = (unsigned short)(u >> 16); }
                else if (sb == 2) { const unsigned u = pg8::cvt_pk_bf16(qe * Fj[0], qe * Fj[1]), u2 = pg8::cvt_pk_bf16(qd, 0.f);
                    *(LAS unsigned short*)(lds + QJ + (32 + rr) * ROWD + d * 2) = (unsigned short)u; *(LAS unsigned short*)(lds + QJ + (64 + 16 + rr) * ROWD + d * 2) = (unsigned short)(u >> 16);
                    *(LAS unsigned short*)(lds + QJ + (112 + rr) * ROWD + d * 2) = (unsigned short)u2; }
                else { const unsigned u = pg8::cvt_pk_bf16(qe * Fj[0], qe * Fj[1]), u2 = pg8::cvt_pk_bf16(qe * Fj[2], qd);
                    *(LAS unsigned short*)(lds + QJ + (48 + rr) * ROWD + d * 2) = (unsigned short)u; *(LAS unsigned short*)(lds + QJ + (64 + 32 + rr) * ROWD + d * 2) = (unsigned short)(u >> 16);
                    *(LAS unsigned short*)(lds + QJ + (112 + 16 + rr) * ROWD + d * 2) = (unsigned short)u2; *(LAS unsigned short*)(lds + QJ + (144 + rr) * ROWD + d * 2) = (unsigned short)(u2 >> 16); }
            }
            klt[r >> 1] = pg8::cvt_pk_bf16(kl[0], kl[1]); vtt[r >> 1] = (unsigned)rv[r] | ((unsigned)rv[r + 1] << 16);
        }
        { LAS v4u* kp = (LAS v4u*)(lds + KLT + d * ROWT + sb * 32); kp[0] = (v4u){klt[0], klt[1], klt[2], klt[3]}; kp[1] = (v4u){klt[4], klt[5], klt[6], klt[7]};
          LAS v4u* vp = (LAS v4u*)(lds + VT + d * ROWT + sb * 32); vp[0] = (v4u){vtt[0], vtt[1], vtt[2], vtt[3]}; vp[1] = (v4u){vtt[4], vtt[5], vtt[6], vtt[7]}; }
        WG_SYNC();
        v2u gate[4];
#pragma unroll
        for (int tt = 0; tt < 4; ++tt) gate[tt] = *(const GAS v2u*)(ZC + (size_t)(row0 + 64 * c + 16 * tt + fr) * DINC + 6144 + h * 128 + 16 * wave + 4 * fq);
        asm volatile("" ::: "memory");
        { const int cn = c + 1 < nch ? c + 1 : c;
          load_raw(rq, rg, rv, ZC + (size_t)(row0 + 64 * cn + 16 * sb) * DINC + h * 128, d); }
#pragma unroll
        for (int rep = 0; rep < 2; ++rep) {
            const int task = wave + 8 * rep;
            if (task < 12) {
                int ti, tj; bool zero = false;
                switch (task) { case 0: ti = 0; tj = 0; break; case 1: ti = 1; tj = 0; break; case 2: ti = 1; tj = 1; break; case 3: ti = 2; tj = 0; break; case 4: ti = 2; tj = 1; break; case 5: ti = 2; tj = 2; break;
                                case 6: ti = 3; tj = 0; break; case 7: ti = 3; tj = 1; break; case 8: ti = 3; tj = 2; break; case 9: ti = 3; tj = 3; break; case 10: ti = 0; tj = 1; zero = true; break; default: ti = 2; tj = 3; zero = true; break; }
                f32x4 sacc = (f32x4){0.f, 0.f, 0.f, 0.f};
                if (!zero) {
                    const int rowb = (tj == 0 ? 0 : tj == 1 ? 64 : tj == 2 ? 112 : 144) + 16 * (ti - tj);
#pragma unroll
                    for (int ks = 0; ks < 4; ++ks) { const bf16x8 af = *(const LAS bf16x8*)(lds + KEND + (16 * tj + fr) * ROWD + ks * 64 + fq * 16);
                        const bf16x8 bfm = *(const LAS bf16x8*)(lds + QJ + (rowb + fr) * ROWD + ks * 64 + fq * 16);
                        sacc = __builtin_amdgcn_mfma_f32_16x16x32_bf16(af, bfm, sacc, 0, 0, 0); }
                    if (ti == tj) {
#pragma unroll
                        for (int e = 0; e < 4; ++e) if (4 * fq + e > fr) sacc[e] = 0.f; }
                }
                v2u w; w.x = pg8::cvt_pk_bf16(sacc[0], sacc[1]); w.y = pg8::cvt_pk_bf16(sacc[2], sacc[3]);
                *(LAS v2u*)(lds + SC + (16 * ti + fr) * ROWT + (16 * tj + 4 * fq) * 2) = w;
            }
        }
        f32x4 oacc[4];
#pragma unroll
        for (int tt = 0; tt < 4; ++tt) oacc[tt] = (f32x4){0.f, 0.f, 0.f, 0.f};
#pragma unroll
        for (int kp = 0; kp < 4; ++kp) {
            v4u w; w.x = pg8::cvt_pk_bf16(S[2 * kp][0], S[2 * kp][1]); w.y = pg8::cvt_pk_bf16(S[2 * kp][2], S[2 * kp][3]); w.z = pg8::cvt_pk_bf16(S[2 * kp + 1][0], S[2 * kp + 1][1]); w.w = pg8::cvt_pk_bf16(S[2 * kp + 1][2], S[2 * kp + 1][3]);
            const bf16x8 af = __builtin_bit_cast(bf16x8, w);
#pragma unroll
            for (int tt = 0; tt < 4; ++tt) { const LAS unsigned char* qp = lds + QT + (16 * tt + fr) * ROWD + (32 * kp + 4 * fq) * 2;
                const v2u lo = *(const LAS v2u*)qp, hi = *(const LAS v2u*)(qp + 32); const v4u qw = {lo.x, lo.y, hi.x, hi.y};
                oacc[tt] = __builtin_amdgcn_mfma_f32_16x16x32_bf16(af, __builtin_bit_cast(bf16x8, qw), oacc[tt], 0, 0, 0); }
        }
        bf16x8 vf[2];
#pragma unroll
        for (int ks = 0; ks < 2; ++ks) vf[ks] = *(const LAS bf16x8*)(lds + VT + (16 * wave + fr) * ROWT + ks * 64 + fq * 16);
#pragma unroll
        for (int a = 0; a < 8; ++a) { const f32x4 dec = *(const LAS f32x4*)(lds + EAL + (16 * a + 4 * fq) * 4); S[a] = S[a] * dec;
#pragma unroll
            for (int ks = 0; ks < 2; ++ks) { const bf16x8 af = *(const LAS bf16x8*)(lds + KLT + (16 * a + fr) * ROWT + ks * 64 + fq * 16);
                S[a] = __builtin_amdgcn_mfma_f32_16x16x32_bf16(af, vf[ks], S[a], 0, 0, 0); } }
        WG_SYNC();
#pragma unroll
        for (int tt = 0; tt < 4; ++tt) {
#pragma unroll
            for (int ks = 0; ks < 2; ++ks) if (ks == 0 || tt >= 2) { const bf16x8 bfm = *(const LAS bf16x8*)(lds + SC + (16 * tt + fr) * ROWT + ks * 64 + fq * 16);
                oacc[tt] = __builtin_amdgcn_mfma_f32_16x16x32_bf16(vf[ks], bfm, oacc[tt], 0, 0, 0); }
            float q2 = (oacc[tt][0] * oacc[tt][0] + oacc[tt][1] * oacc[tt][1]) + (oacc[tt][2] * oacc[tt][2] + oacc[tt][3] * oacc[tt][3]);
            q2 += __shfl_xor(q2, 16); q2 += __shfl_xor(q2, 32);
            if (fq == 0) ssq[wave * 64 + 16 * tt + fr] = q2;
        }
        WG_SYNC();
#pragma unroll
        for (int tt = 0; tt < 4; ++tt) { float q2 = 0.f;
#pragma unroll
            for (int w = 0; w < 8; ++w) q2 += ssq[w * 64 + 16 * tt + fr];
            const float rstd = __builtin_amdgcn_rsqf(q2 * (1.f / 128.f) + EPS);
            v2u w; w.x = pg8::cvt_pk_bf16(oacc[tt][0] * rstd * gov[0] * bflo(gate[tt].x), oacc[tt][1] * rstd * gov[1] * bfhi(gate[tt].x)); w.y = pg8::cvt_pk_bf16(oacc[tt][2] * rstd * gov[2] * bflo(gate[tt].y), oacc[tt][3] * rstd * gov[3] * bfhi(gate[tt].y));
            *(GAS v2u*)(OB + (size_t)(row0 + 64 * c + 16 * tt + fr) * D + h * 128 + 16 * wave + 4 * fq) = w; }
    }
#pragma unroll
    for (int a = 0; a < 8; ++a)
#pragma unroll
        for (int e = 0; e < 4; ++e) sout[(16 * a + 4 * fq + e) * 128 + 16 * wave + fr] = S[a][e];
    __syncthreads();
}
}

__device__ __forceinline__ void load8f(const bf16* p, float (&v)[8]) { const v4u w = *(const GAS v4u*)p; v[0] = bflo(w.x); v[1] = bfhi(w.x); v[2] = bflo(w.y); v[3] = bfhi(w.y); v[4] = bflo(w.z); v[5] = bfhi(w.z); v[6] = bflo(w.w); v[7] = bfhi(w.w); }
__device__ __forceinline__ void cu_row(const bf16* zrow, int c0, float (&cu)[8]) { float a[8], b[8]; load8f(zrow + 1024 + c0, a); load8f(zrow + 2048 + c0, b);
#pragma unroll
    for (int j = 0; j < 8; ++j) cu[j] = a[j] * b[j]; }
__device__ __forceinline__ void mixa_conv_strip(int m0, int e, const bf16* ZA, const float* cache_conv, const float* w_conv, bf16* CAT, float* out, int lane) {
    const bool smp = m0 >= MP; const int mm = smp ? m0 - MP : m0;
    const int b = smp ? mm >> 6 : mm >> 11, t0 = smp ? mm & 63 : mm & 2047, T = smp ? DSEQ : SEQ;
    const float* wc = w_conv + (size_t)e * 3 * DCONV;
#pragma unroll
    for (int half = 0; half < 2; ++half) {
        const int c0 = 512 * half + 8 * lane;
        float cu1[8], cu2[8], w0[8], w1[8], w2[8];
#pragma unroll
        for (int j = 0; j < 8; ++j) { w0[j] = wc[c0 + j]; w1[j] = wc[DCONV + c0 + j]; w2[j] = wc[2 * DCONV + c0 + j]; }
        if (t0 >= 2) { cu_row(ZA + (size_t)(m0 - 1) * DINA_P, c0, cu1); cu_row(ZA + (size_t)(m0 - 2) * DINA_P, c0, cu2); }
        else {
#pragma unroll
            for (int j = 0; j < 8; ++j) { cu1[j] = smp ? cache_conv[((size_t)(e * DB + b) * 2 + 1) * DCONV + c0 + j] : 0.f; cu2[j] = smp ? cache_conv[((size_t)(e * DB + b) * 2 + 0) * DCONV + c0 + j] : 0.f; } }
#pragma unroll
        for (int r = 0; r < 4; ++r) { const int m = m0 + r, t = t0 + r; const bf16* zrow = ZA + (size_t)m * DINA_P;
            float gb[8], cu0[8], y[8];
            load8f(zrow + c0, gb); cu_row(zrow, c0, cu0);
#pragma unroll
            for (int j = 0; j < 8; ++j) y[j] = gb[j] * (w0[j] * cu2[j] + w1[j] * cu1[j] + w2[j] * cu0[j]);
            v4u w; w.x = pk2(y[0], y[1]); w.y = pk2(y[2], y[3]); w.z = pk2(y[4], y[5]); w.w = pk2(y[6], y[7]);
            *(GAS v4u*)(CAT + (size_t)m * D + c0) = w;
            if (t >= T - 2) { float* cs = out + (smp ? O_CONVS + ((size_t)(e * DB + b) * 2 + (t - (T - 2))) * DCONV : O_CONVP + ((size_t)(e * NB + b) * 2 + (t - (T - 2))) * DCONV) + c0;
                *(GAS f32x4*)cs = (f32x4){cu0[0], cu0[1], cu0[2], cu0[3]}; *(GAS f32x4*)(cs + 4) = (f32x4){cu0[4], cu0[5], cu0[6], cu0[7]}; }
#pragma unroll
            for (int j = 0; j < 8; ++j) { cu2[j] = cu1[j]; cu1[j] = cu0[j]; }
        }
    }
}
__device__ __forceinline__ void mixa_row(int m, int e, const bf16* ZA, const float* g_q, const float* g_kv, const float* rope,
                                         bf16* CQN, bf16* KVIN, bf16* KPEB, float* out, int lane) {
    const bool smp = m >= MP; const int mm = smp ? m - MP : m;
    const int b = smp ? mm >> 6 : mm >> 11, t = smp ? mm & 63 : mm & 2047;
    const int kvrow = smp ? MP + b * KVS + PAST + t : m, pos = smp ? PAST + t : t;
    const bf16* zrow = ZA + (size_t)m * DINA_P;
    {
        float v[8]; load8f(zrow + 3072 + 8 * lane, v); float s = 0.f;
#pragma unroll
        for (int j = 0; j < 8; ++j) s += v[j] * v[j];
        const float rstd = 1.0f / sqrtf(wave_sum(s) * (1.f / QL) + EPS); const float* g = g_q + e * QL + 8 * lane;
        v4u w; w.x = pk2(v[0] * rstd * g[0], v[1] * rstd * g[1]); w.y = pk2(v[2] * rstd * g[2], v[3] * rstd * g[3]); w.z = pk2(v[4] * rstd * g[4], v[5] * rstd * g[5]); w.w = pk2(v[6] * rstd * g[6], v[7] * rstd * g[7]);
        *(GAS v4u*)(CQN + (size_t)m * QL + 8 * lane) = w;
    }
    {
        float v[8]; load8f(zrow + 3584 + 8 * lane, v); float s = 0.f;
#pragma unroll
        for (int j = 0; j < 8; ++j) s += v[j] * v[j];
        const float rstd = 1.0f / sqrtf(wave_sum(s) * (1.f / KVL) + EPS); const float* g = g_kv + e * KVL + 8 * lane;
#pragma unroll
        for (int j = 0; j < 8; ++j) v[j] = v[j] * rstd * g[j];
        v4u w; w.x = pk2(v[0], v[1]); w.y = pk2(v[2], v[3]); w.z = pk2(v[4], v[5]); w.w = pk2(v[6], v[7]);
        *(GAS v4u*)(KVIN + (size_t)kvrow * KVL + 8 * lane) = w;
        float* co = out + (smp ? O_CKVS + ((size_t)(e * DB + b) * DSEQ + t) * KVL : O_CKVP + ((size_t)(e * NB + b) * SEQ + t) * KVL) + 8 * lane;
        *(GAS f32x4*)co = (f32x4){v[0], v[1], v[2], v[3]}; *(GAS f32x4*)(co + 4) = (f32x4){v[4], v[5], v[6], v[7]};
    }
    if (lane < 32) {
        const float x1 = bf2f(zrow[4096 + lane]), x2 = bf2f(zrow[4096 + 32 + lane]);
        const float c = rope[(size_t)pos * 64 + 2 * lane], s = rope[(size_t)pos * 64 + 2 * lane + 1];
        const float r1 = x1 * c - x2 * s, r2 = x1 * s + x2 * c;
        float* ko = out + (smp ? O_KPES + ((size_t)(e * DB + b) * DSEQ + t) * ROPE : O_KPEP + ((size_t)(e * NB + b) * SEQ + t) * ROPE);
        ko[lane] = r1; ko[32 + lane] = r2;
        KPEB[(size_t)kvrow * ROPE + lane] = (bf16)f2bf(r1); KPEB[(size_t)kvrow * ROPE + 32 + lane] = (bf16)f2bf(r2);
    }
}

#ifndef REP_ATT
#define REP_ATT 1
#endif
#ifndef REP_GLA
#define REP_GLA 1
#endif
#ifndef REP_MIXA
#define REP_MIXA 1
#endif
#ifndef REP_NORM
#define REP_NORM 1
#endif
#ifndef REP_PRO
#define REP_PRO 1
#endif
#ifndef REP_GU
#define REP_GU 1
#endif
#ifndef STAG_ON
#define STAG_ON 0
#endif
#ifndef STAG_GU
#define STAG_GU 100
#endif
#ifndef STAG_RES
#define STAG_RES 250
#endif
#ifndef STAG_IN
#define STAG_IN 150
#endif
#ifndef WGM_GU
#define WGM_GU 4
#endif
#ifndef MK_ONE_LAUNCH
#define MK_ONE_LAUNCH 1
#endif
constexpr int N_PHASES = 1 + 8 * 2 + 2 * 5 + 2 * 3 + 1;

#define PH_LOCALS \
    const CAS Args* ap_ = (const CAS Args*)__builtin_amdgcn_kernarg_segment_ptr(); asm volatile("" : "+s"(ap_)); const CAS Args& args = *ap_;   \
    int tid = threadIdx.x; asm volatile("" : "+v"(tid)); const int lane = tid & 63, wave = __builtin_amdgcn_readfirstlane(tid >> 6); \
    GAS unsigned char* ws_ = (GAS unsigned char*)args.ws; asm volatile("" : "+s"(ws_)); unsigned char* ws = (unsigned char*)ws_;   \
    GAS float* X_ = (GAS float*)args.out; asm volatile("" : "+s"(X_)); float* X = (float*)X_; \
    int G = gridDim.x; asm volatile("" : "+s"(G)); int bid = blockIdx.x; asm volatile("" : "+s"(bid)); \
    const int gw = bid * NWAVES + wave, NGW = G * NWAVES; LAS unsigned char* lds = (LAS unsigned char*)lds_raw; \
    bf16* XN = (bf16*)(ws + WS_XN); bf16* CAT = (bf16*)(ws + WS_CAT); pg8::ssq_t* SSQ = (pg8::ssq_t*)(ws + WS_SS); (void)lane; (void)gw; (void)NGW; (void)XN; (void)CAT; (void)SSQ; (void)X; (void)lds;

#define PH_L int lq_ = l; asm volatile("" : "+s"(lq_)); const int l = lq_; const int e = l >> 1, o = l >> 1; (void)e; (void)o;
__global__ void __launch_bounds__(NTHR, 2) mega_fwd(Args kargs) {
    extern __shared__ __attribute__((aligned(16))) unsigned char lds_raw[];
    XcdBarrier bar;
    {
        volatile LAS unsigned* MISC = (volatile LAS unsigned*)((LAS unsigned char*)lds_raw + MISC_OFF);
        if (threadIdx.x < 32) MISC[threadIdx.x] = 0u;
        __syncthreads();
        bar.bar = (unsigned*)(kargs.ws + WS_CTL) + CW_BAR; bar.x = 0; bar.st = nullptr;
        if (MK_ONE_LAUNCH) bar = xcd_barrier_post((unsigned*)(kargs.ws + WS_CTL) + CW_BAR, MISC + 8);
    }
    const int lo = kargs.ph_lo, hi = kargs.ph_hi;
    int ph = 0;
#define IN_PHASE (ph >= lo && ph < hi)
#define STAGGER(T_) do { if (STAG_ON) { const unsigned long long t0_ = __builtin_amdgcn_s_memrealtime(); const unsigned long long d_ = (unsigned long long)((blockIdx.x >> 3) & 3u) * (T_); while (__builtin_amdgcn_s_memrealtime() - t0_ < d_) __builtin_amdgcn_s_sleep(2); } } while (0)
#define END_PHASE do { if (MK_ONE_LAUNCH && ph + 1 < hi && ph + 1 < N_PHASES) { XcdBarrier b2_ = bar; GAS unsigned* bb_ = (GAS unsigned*)bar.bar; asm volatile("" : "+s"(bb_)); b2_.bar = (unsigned*)bb_; asm volatile("" : "+s"(b2_.x)); xcd_barrier(b2_); } ++ph; } while (0)

    if (IN_PHASE) {
        PH_LOCALS
        cv_group(args.in, ws, 0, (unsigned*)(ws + WS_CTL) + CW_CONV, lds + RING_OFF + wave * 16384, lane);
        const size_t gt = (size_t)bid * NTHR + tid, GT = (size_t)G * NTHR;
        for (size_t i = gt; i < (size_t)2 * (DINA_P - DINA) * D / 8; i += GT) { const size_t e = i / ((DINA_P - DINA) * D / 8), j = i % ((DINA_P - DINA) * D / 8);
            *(GAS v4u*)((bf16*)(ws + WS_WINA) + e * DINA_P * D + (size_t)DINA * D + j * 8) = (v4u){0u, 0u, 0u, 0u}; }
        for (int m = gw; m < M; m += NGW) x_row_init(m < MP ? args.in[I_XP] + (size_t)m * D : args.in[I_XS] + (size_t)(m - MP) * D, XN + (size_t)m * D, SSQ + (size_t)m * 8, lane);
        for (size_t i = gt; i < (size_t)KVS * 32; i += GT) { const int pos = (int)(i >> 5), k = (int)(i & 31); const double inv = exp(-(double)k * (9.210340371976184 / 32.0)), ang = (double)pos * inv;
            float* rp = (float*)(ws + WS_ROPE) + 2 * i; rp[0] = (float)cos(ang); rp[1] = (float)sin(ang); }
        for (size_t i = gt; i < 2048; i += GT) { const float a = args.in[I_LB][i], b2 = args.in[I_LB][2048 + i]; float* lbp = (float*)(ws + WS_LB);
            lbp[i] = 0.f; lbp[2048 + i] = 1.0f / (1.0f + expf(a - b2)); }
    }
    END_PHASE;

#define FFN_STEP(F_) { \
        if (IN_PHASE) { PH_LOCALS PH_L const int inst = (F_) * 4 + l; pg8::Gemm g{XN, (const bf16*)(ws + WS_WGU) + (size_t)inst * 2 * DFF * D, M, 2 * DFF, D, D, D}; pg8::StaticOrder S; S.init(M, 2 * DFF, G, bid, WGM_GU); \
            pg8::EpiSwiGLU E{(bf16*)(ws + WS_H), DFF, SSQ + (size_t)(3 * l + 2 * (F_)) * M * 8}; STAGGER(STAG_GU); for (int rep_ = 0; rep_ < REP_GU; ++rep_) pg8::gemm_phase<pg8::EpiSwiGLU, pg8::StaticOrder, true, true>(lds + RING_OFF, g, S, E); } \
        END_PHASE; \
        if (IN_PHASE) { PH_LOCALS PH_L const int inst = (F_) * 4 + l; pg8::Gemm g{(const bf16*)(ws + WS_H), (const bf16*)(ws + WS_WD) + (size_t)inst * D * DFF, M, D, DFF, DFF, DFF}; pg8::StaticOrder S; S.init(M, D, G, bid); \
            const int site = 3 * l + 2 * (F_) + 1; pg8::EpiResidNorm E{XN, SSQ + (size_t)site * M * 8, D, 0.5f, (PG8_LAS float*)(lds + EPI_P_OFF)}; STAGGER(STAG_RES); pg8::gemm_phase<pg8::EpiResidNorm, pg8::StaticOrder, true, true>(lds + RING_OFF, g, S, E); \
            const int cg = 1 + 2 * l + (F_); if (cg < 8) cv_group(args.in, ws, cg, (unsigned*)(ws + WS_CTL) + CW_CONV + 64 * cg, lds + RING_OFF + wave * 16384, lane, (F_) ? 0 : 1); } \
        END_PHASE; }

    for (int l = 0; l < DEPTH; ++l) {
        FFN_STEP(0)
        if ((l & 1) == 0) {
            const int e = l >> 1;
            if (IN_PHASE) { PH_LOCALS PH_L pg8::Gemm g{XN, (const bf16*)(ws + WS_WINA) + (size_t)e * DINA_P * D, M, DINA_P, D, D, D}; pg8::StaticOrder S; S.init(M, DINA_P, G, bid);
                pg8::EpiStore E{(bf16*)(ws + WS_ZA), DINA_P, SSQ + (size_t)(3 * l + 1) * M * 8}; STAGGER(STAG_IN); pg8::gemm_phase<pg8::EpiStore, pg8::StaticOrder, true, true>(lds + RING_OFF, g, S, E); }
            END_PHASE;
            if (IN_PHASE) { PH_LOCALS PH_L
                bf16* ZA = (bf16*)(ws + WS_ZA); bf16* CQN = (bf16*)(ws + WS_CQN); bf16* KVIN = (bf16*)(ws + WS_KVIN); bf16* KPEB = (bf16*)(ws + WS_KPEB); const float* rope = (const float*)(ws + WS_ROPE);
                for (int rep = 0; rep < REP_MIXA; ++rep)
                for (int st = gw; st < M / 4; st += NGW) { mixa_conv_strip(4 * st, e, ZA, args.in[I_CCONV], args.in[I_WCONV], CAT, X, lane);
                    for (int r = 0; r < 4; ++r) mixa_row(4 * st + r, e, ZA, args.in[I_GQ], args.in[I_GKV], rope, CQN, KVIN, KPEB, X, lane); }
                for (int r = gw; r < DB * PAST; r += NGW) { const int b = r >> 12, s = r & 4095; const size_t kvrow = (size_t)MP + (size_t)b * KVS + s;
                    const float* src = args.in[I_CCKV] + ((size_t)(e * DB + b) * PAST + s) * KVL + 8 * lane; const f32x4 a = *(const GAS f32x4*)src, c = *(const GAS f32x4*)(src + 4);
                    v4u w; w.x = pk2(a.x, a.y); w.y = pk2(a.z, a.w); w.z = pk2(c.x, c.y); w.w = pk2(c.z, c.w); *(GAS v4u*)(KVIN + kvrow * KVL + 8 * lane) = w;
                    KPEB[kvrow * ROPE + lane] = (bf16)f2bf(args.in[I_CKPE][((size_t)(e * DB + b) * PAST + s) * ROPE + lane]); }
            }
            END_PHASE;
            if (IN_PHASE) { PH_LOCALS PH_L
                { pg8::Gemm g{(const bf16*)(ws + WS_CQN), (const bf16*)(ws + WS_WUQ) + (size_t)e * 1536 * QL, M, 1536, QL, QL, QL}; pg8::StaticOrder S; S.init(M, 1536, G, bid);
                  pg8::EpiStore E{(bf16*)(ws + WS_QB), 1536, nullptr}; pg8::gemm_phase<pg8::EpiStore, pg8::StaticOrder, true, true>(lds + RING_OFF, g, S, E); }
                { pg8::Gemm g{(const bf16*)(ws + WS_KVIN), (const bf16*)(ws + WS_WUKV) + (size_t)e * 2048 * KVL, KVROWS, 1024, KVL, KVL, KVL}; pg8::StaticOrder S; S.init(KVROWS, 1024, G, bid);
                  pg8::EpiStore E{(bf16*)(ws + WS_KNOPE), 1024, nullptr}; pg8::gemm_phase<pg8::EpiStore, pg8::StaticOrder, true, true>(lds + RING_OFF, g, S, E); }
                { pg8::Gemm g{(const bf16*)(ws + WS_WUKV) + (size_t)e * 2048 * KVL + (size_t)1024 * KVL, (const bf16*)(ws + WS_KVIN), 1024, KVROWS, KVL, KVL, KVL}; pg8::StaticOrder S; S.init(1024, KVROWS, G, bid);
                  pg8::EpiStore E{(bf16*)(ws + WS_VT), KVROWS, nullptr}; pg8::gemm_phase<pg8::EpiStore, pg8::StaticOrder, true, true>(lds + RING_OFF, g, S, E); }
            }
            END_PHASE;
            if (IN_PHASE) { PH_LOCALS PH_L
                for (int rep = 0; rep < REP_ATT; ++rep) {
                unsigned* ctr = (unsigned*)(ws + WS_CTL) + CW_ATTN + 64 * e + 1024 * rep;
                LAS unsigned* uw = (LAS unsigned*)(lds + att::UNIT_OFF);
                for (;;) {
                    if (tid == 0) *uw = atomicAdd(ctr, 1u);
                    LDS_WAIT(); __syncthreads();
                    const int unit = __builtin_amdgcn_readfirstlane((int)*uw);
                    __syncthreads();
                    if (unit >= att::NUNITS) break;
                    int tid_u = tid; asm volatile("" : "+v"(tid_u)); const int lane_u = tid_u & 63;
                    if (unit < DB * HEADS) att::attn_unit<false>(unit, lds, (const bf16*)(ws + WS_QB), (const bf16*)(ws + WS_KNOPE), (const bf16*)(ws + WS_KPEB), (const bf16*)(ws + WS_VT), (const float*)(ws + WS_ROPE), CAT, tid_u, wave, lane_u);
                    else att::attn_unit<true>(unit, lds, (const bf16*)(ws + WS_QB), (const bf16*)(ws + WS_KNOPE), (const bf16*)(ws + WS_KPEB), (const bf16*)(ws + WS_VT), (const float*)(ws + WS_ROPE), CAT, tid_u, wave, lane_u);
                }
                }
            }
            END_PHASE;
            if (IN_PHASE) { PH_LOCALS PH_L pg8::Gemm g{CAT, (const bf16*)(ws + WS_WOA) + (size_t)e * D * D, M, D, D, D, D}; pg8::StaticOrder S; S.init(M, D, G, bid);
                pg8::EpiResidNorm E{XN, SSQ + (size_t)(3 * l + 2) * M * 8, D, 1.0f, (PG8_LAS float*)(lds + EPI_P_OFF)}; STAGGER(STAG_RES); pg8::gemm_phase<pg8::EpiResidNorm, pg8::StaticOrder, true, true>(lds + RING_OFF, g, S, E);
                cv_group(args.in, ws, 1 + 2 * l, (unsigned*)(ws + WS_CTL) + CW_CONV + 64 * (8 + l), lds + RING_OFF + wave * 16384, lane, 2); }
            END_PHASE;
        } else {
            const int o = l >> 1;
            if (IN_PHASE) { PH_LOCALS PH_L pg8::Gemm g{XN, (const bf16*)(ws + WS_WINC) + (size_t)o * DINC * D, M, DINC, D, D, D}; pg8::StaticOrder S; S.init(M, DINC, G, bid);
                pg8::EpiGla E{(bf16*)(ws + WS_ZC), DINC, (const float*)(ws + WS_LB) + o * 2048, SSQ + (size_t)(3 * l + 1) * M * 8}; STAGGER(STAG_IN); pg8::gemm_phase<pg8::EpiGla, pg8::StaticOrder, true, true>(lds + RING_OFF, g, S, E); }
            END_PHASE;
            if (IN_PHASE) { PH_LOCALS PH_L
                for (int rep = 0; rep < REP_GLA; ++rep) {
                unsigned* ctr = (unsigned*)(ws + WS_CTL) + CW_GLA + 64 * o + 1024 * rep;
                LAS unsigned* uw = (LAS unsigned*)(lds + gla::UNIT);
                for (;;) {
                    if (tid == 0) *uw = atomicAdd(ctr, 1u);
                    LDS_WAIT(); __syncthreads();
                    const int unit = __builtin_amdgcn_readfirstlane((int)*uw);
                    __syncthreads();
                    if (unit >= gla::NUNITS) break;
                    gla::gla_unit(unit, lds, (const bf16*)(ws + WS_ZC), args.in[I_SHG] + (size_t)o * DB * HGH * HGD * HGD, args.in[I_GO] + o * HGD, CAT,
                                  X + O_HGP + (size_t)o * NB * HGH * HGD * HGD, X + O_HGS + (size_t)o * DB * HGH * HGD * HGD, tid, wave, lane);
                }
                }
            }
            END_PHASE;
            if (IN_PHASE) { PH_LOCALS PH_L pg8::Gemm g{CAT, (const bf16*)(ws + WS_WOC) + (size_t)o * D * D, M, D, D, D, D}; pg8::StaticOrder S; S.init(M, D, G, bid);
                pg8::EpiResidNorm E{XN, SSQ + (size_t)(3 * l + 2) * M * 8, D, 1.0f, (PG8_LAS float*)(lds + EPI_P_OFF)}; STAGGER(STAG_RES); pg8::gemm_phase<pg8::EpiResidNorm, pg8::StaticOrder, true, true>(lds + RING_OFF, g, S, E);
                cv_group(args.in, ws, 1 + 2 * l, (unsigned*)(ws + WS_CTL) + CW_CONV + 64 * (8 + l), lds + RING_OFF + wave * 16384, lane, 2); }
            END_PHASE;
        }
        FFN_STEP(1)
    }
#undef FFN_STEP
    if (IN_PHASE) { PH_LOCALS
        const float* gain = args.in[I_NFIN]; const pg8::ssq_t* ssf = SSQ + (size_t)12 * M * 8;
        for (int m = gw; m < M; m += NGW) { const GAS v2u* xr = (const GAS v2u*)(XN + (size_t)m * D) + lane; GAS f32x4* yo = (GAS f32x4*)(X + (size_t)m * D) + lane; const GAS f32x4* gr = (const GAS f32x4*)gain + lane;
            const float rstd = pg8::row_rstd(ssf, m);
#pragma unroll
            for (int j = 0; j < 8; ++j) { const v2u w = xr[64 * j]; const f32x4 g = gr[64 * j]; yo[64 * j] = (f32x4){bflo(w.x) * rstd * g.x, bfhi(w.x) * rstd * g.y, bflo(w.y) * rstd * g.z, bfhi(w.y) * rstd * g.w}; } }
    }
    ++ph;
#undef IN_PHASE
#undef END_PHASE
}

extern "C" void kernel_launch(void* const* d_in, const int* in_sizes, int n_in, void* d_out, int out_size, void* d_ws, size_t ws_size, hipStream_t stream) {
    static int grid = 0;
    if (grid == 0) {
        if (n_in != N_IN || (size_t)out_size != O_END || ws_size < WS_TOTAL) { fprintf(stderr, "kernel_launch: unexpected shapes (n_in %d, out %d, ws %zu); nothing launched\n", n_in, out_size, ws_size); grid = -1; return; }
        int dev = 0, cus = 0, per_cu = 0;
        if (hipGetDevice(&dev) != hipSuccess || hipDeviceGetAttribute(&cus, hipDeviceAttributeMultiprocessorCount, dev) != hipSuccess) { grid = -1; return; }
        if (hipFuncSetAttribute((const void*)mega_fwd, hipFuncAttributeMaxDynamicSharedMemorySize, LDS_BYTES) != hipSuccess) { fprintf(stderr, "kernel_launch: hipFuncSetAttribute failed\n"); grid = -1; return; }
        if (hipOccupancyMaxActiveBlocksPerMultiprocessor(&per_cu, (const void*)mega_fwd, NTHR, LDS_BYTES) != hipSuccess || per_cu < 1) { fprintf(stderr, "kernel_launch: occupancy query says %d\n", per_cu); (void)hipGetLastError(); grid = -1; return; }
        grid = cus;
    }
    if (grid < 0) return;
    if (hipMemsetAsync((char*)d_ws + WS_CTL, 0, CTL_ZERO_BYTES, stream) != hipSuccess) return;
    Args a{};
    for (int i = 0; i < N_IN; ++i) a.in[i] = (const float*)d_in[i];
    a.out = (float*)d_out; a.ws = (unsigned char*)d_ws;
#if MK_ONE_LAUNCH
    a.ph_lo = 0; a.ph_hi = N_PHASES;
    hipLaunchKernelGGL(mega_fwd, dim3(grid), dim3(NTHR), LDS_BYTES, stream, a);
#else
    for (int p = 0; p < N_PHASES; ++p) { a.ph_lo = p; a.ph_hi = p + 1; hipLaunchKernelGGL(mega_fwd, dim3(grid), dim3(NTHR), LDS_BYTES, stream, a); }
#endif
}
```

```cpp
#include <hip/hip_runtime.h>
#include <cstdio>
#include <cstdint>
namespace pg8 {
#define PG8_LAS __attribute__((address_space(3)))
typedef unsigned short bf16_t;
typedef short bf16x8 __attribute__((ext_vector_type(8)));
typedef float f32x4 __attribute__((ext_vector_type(4)));
typedef unsigned u32x4 __attribute__((ext_vector_type(4)));
constexpr int BM = 256, BK = 64, HALF = 128, HTB = HALF * BK * 2  , STAGE_BYTES = 8 * HTB, NXCD = 8, WGM = 8;

__host__ __device__ __forceinline__ int lds_byte(int r, int c) { const int st = (r >> 4) * 2 + (c >> 5), rr = r & 15, cc = c & 31, ob = rr * 64 + cc * 2; return st * 1024 + (ob ^ (((ob >> 9) & 1) << 5)); }
__host__ __device__ __forceinline__ void stage_rc(int b, int& R, int& C) { const int st = b / 1024, sb = b % 1024, swz = sb ^ (((sb >> 9) & 1) << 5); R = (st >> 1) * 16 + swz / 64; C = (st & 1) * 32 + (swz % 64) / 2; }
__host__ __device__ __forceinline__ int perm32(int rho) { const int n = rho >> 4, i = rho & 15; return 8 * (i >> 2) + 4 * n + (i & 3); }

struct Unit { int pm, pn; };
struct Gemm { const bf16_t* A; const bf16_t* Bt; int M, N, K, lda, ldb; };

struct StaticOrder {
    int nM, nN, nwg, G, c, wgm;
    __host__ __device__ void init(int M, int N, int G_, int c_, int wgm_ = 4) { nM = M / BM; nN = N / BM; nwg = nM * nN; G = G_; c = c_; wgm = wgm_; }
    __host__ __device__ bool next(int i, Unit& u) const {
        const long L = (long)i * G + c; if (L >= nwg) return false;
        int wgid = (int)L; { const int q = nwg / NXCD, r = nwg % NXCD, xcd = wgid % NXCD, off = wgid / NXCD; wgid = (xcd < r ? xcd * (q + 1) : r * (q + 1) + (xcd - r) * q) + off; }
        const int nig = wgm * nN, gid = wgid / nig, fm = gid * wgm, gsz = (nM - fm) < wgm ? (nM - fm) : wgm;
        u.pm = fm + ((wgid % nig) % gsz); u.pn = (wgid % nig) / gsz; return true;
    }
    __device__ __forceinline__ void a_ready(const Unit&) const {}
    __device__ __forceinline__ void done(const Unit&) const {}
};

typedef float f32x2_t __attribute__((ext_vector_type(2))); typedef __bf16 bf16x2_t __attribute__((ext_vector_type(2)));
__device__ __forceinline__ unsigned cvt_pk_bf16(float lo, float hi) { const f32x2_t v = {lo, hi}; const bf16x2_t b = __builtin_convertvector(v, bf16x2_t); return __builtin_bit_cast(unsigned, b); }
typedef float f32x2 __attribute__((ext_vector_type(2)));
__device__ __forceinline__ float fast_sigmoid(float x) { return __builtin_amdgcn_rcpf(1.0f + __builtin_amdgcn_exp2f(-1.44269504089f * x)); }
__device__ __forceinline__ float fast_silu(float x) { return x * fast_sigmoid(x); }

typedef float ssq_t;
__device__ __forceinline__ float row_rstd(const ssq_t* ssp, int row) { const f32x4 a = *(const f32x4*)(ssp + (size_t)row * 8), b = *(const f32x4*)(ssp + (size_t)row * 8 + 4);
    return __builtin_amdgcn_rsqf((((a[0] + a[1]) + (a[2] + a[3])) + ((b[0] + b[1]) + (b[2] + b[3]))) * (1.0f / 2048.0f) + 1e-6f); }

struct RsRaw { f32x4 a, b; };
__device__ __forceinline__ RsRaw rs_issue(const ssq_t* ssp, const Unit& u, int wid, int lane) { RsRaw r; const ssq_t* p = ssp + (size_t)(u.pm * BM + wid * 32 + (lane & 31)) * 8; r.a = *(const f32x4*)p; r.b = *(const f32x4*)(p + 4); return r; }
__device__ __forceinline__ void rs_finish(const RsRaw& r, PG8_LAS float* rsbuf, int wid, int lane) { const f32x4 a = r.a, b = r.b;
    const float rs = __builtin_amdgcn_rsqf((((a[0] + a[1]) + (a[2] + a[3])) + ((b[0] + b[1]) + (b[2] + b[3]))) * (1.0f / 2048.0f) + 1e-6f); if (lane < 32) rsbuf[wid * 32 + lane] = rs; }
struct NoRaw {};

struct EpiStore {
    static constexpr bool PERM = true, AFTER_DRAIN = false; static constexpr int NSTORES = 16;
    bf16_t* O; int ldc; const ssq_t* ss;
    typedef RsRaw Raw;
    __device__ __forceinline__ Raw issue(const Unit& u, int wid, int lane) const { if (ss) return rs_issue(ss, u, wid, lane); return Raw{(f32x4){0.f, 0.f, 0.f, 0.f}, (f32x4){0.f, 0.f, 0.f, 0.f}}; }
    __device__ __forceinline__ void finish(const Raw& r, PG8_LAS float* rsbuf, int wid, int lane) const { if (ss) rs_finish(r, rsbuf, wid, lane); }
    __device__ __forceinline__ void operator()(const f32x4 (&acc)[2][2][4][2], const Unit& u, int wr, int wc, int fr, int fq, const PG8_LAS float* rsbuf) const {
        const int row0 = u.pm * BM + wr * 64 + fr, col0 = u.pn * BM + wc * 32 + 8 * fq;
#pragma unroll
        for (int ai = 0; ai < 2; ++ai)
#pragma unroll
            for (int m = 0; m < 4; ++m) { const int row = row0 + ai * HALF + m * 16; bf16_t* rowp = O + (size_t)row * ldc + col0; const float rs = ss ? rsbuf[ai * HALF + wr * 64 + m * 16 + fr] : 1.0f;
#pragma unroll
                for (int bj = 0; bj < 2; ++bj) { const f32x4 v0 = acc[ai][bj][m][0] * rs, v1 = acc[ai][bj][m][1] * rs;
                    u32x4 w; w.x = cvt_pk_bf16(v0[0], v0[1]); w.y = cvt_pk_bf16(v0[2], v0[3]); w.z = cvt_pk_bf16(v1[0], v1[1]); w.w = cvt_pk_bf16(v1[2], v1[3]);
                    *(u32x4*)(rowp + bj * HALF) = w; } }
    }
};
struct EpiSwiGLU {
    static constexpr bool PERM = true, AFTER_DRAIN = false; static constexpr int NSTORES = 8;
    bf16_t* O; int ldc; const ssq_t* ss;
    typedef RsRaw Raw;
    __device__ __forceinline__ Raw issue(const Unit& u, int wid, int lane) const { return rs_issue(ss, u, wid, lane); }
    __device__ __forceinline__ void finish(const Raw& r, PG8_LAS float* rsbuf, int wid, int lane) const { rs_finish(r, rsbuf, wid, lane); }
    __device__ __forceinline__ void operator()(const f32x4 (&acc)[2][2][4][2], const Unit& u, int wr, int wc, int fr, int fq, const PG8_LAS float* rsbuf) const {
        const int row0 = u.pm * BM + wr * 64 + fr;
        bf16_t* const tile0 = O + ((size_t)(u.pm * (ldc >> 6) + 2 * u.pn + (wc >> 1)) * BM + wr * 64 + fr) * BK + 32 * (wc & 1) + 8 * fq;
#pragma unroll
        for (int ai = 0; ai < 2; ++ai)
#pragma unroll
            for (int m = 0; m < 4; ++m) { bf16_t* rowp = tile0 + (ai * HALF + m * 16) * BK; const float rs = rsbuf[ai * HALF + wr * 64 + m * 16 + fr];
                const float rsl = rs * -1.44269504089f, rs2 = rs * rs;
                f32x4 h0, h1;
#pragma unroll
                for (int n = 0; n < 2; ++n)
#pragma unroll
                    for (int jj = 0; jj < 2; ++jj) { const f32x2 g = {acc[ai][0][m][n][2 * jj], acc[ai][0][m][n][2 * jj + 1]}, u = {acc[ai][1][m][n][2 * jj], acc[ai][1][m][n][2 * jj + 1]};
                        const f32x2 t = g * rsl; f32x2 e; e.x = __builtin_amdgcn_exp2f(t.x); e.y = __builtin_amdgcn_exp2f(t.y);
                        const f32x2 d = e + 1.0f; f32x2 r; r.x = __builtin_amdgcn_rcpf(d.x); r.y = __builtin_amdgcn_rcpf(d.y);
                        const f32x2 hh = (g * u) * (r * rs2);
                        if (n == 0) { h0[2 * jj] = hh.x; h0[2 * jj + 1] = hh.y; } else { h1[2 * jj] = hh.x; h1[2 * jj + 1] = hh.y; } }
                u32x4 w; w.x = cvt_pk_bf16(h0[0], h0[1]); w.y = cvt_pk_bf16(h0[2], h0[3]); w.z = cvt_pk_bf16(h1[0], h1[1]); w.w = cvt_pk_bf16(h1[2], h1[3]);
                *(u32x4*)rowp = w; }
    }
};
struct EpiResidNorm {
    static constexpr bool PERM = true, AFTER_DRAIN = false; static constexpr int NSTORES = 16;
    bf16_t* XB; ssq_t* ss; int ldc; float scale; PG8_LAS float* P;
    typedef NoRaw Raw;
    __device__ __forceinline__ Raw issue(const Unit&, int, int) const { return Raw{}; }
    __device__ __forceinline__ void finish(const Raw&, PG8_LAS float*, int, int) const {}
    __device__ __forceinline__ void operator()(const f32x4 (&acc)[2][2][4][2], const Unit& u, int wr, int wc, int fr, int fq, const PG8_LAS float*) const {
        const int row0 = u.pm * BM + wr * 64 + fr, col0 = u.pn * BM + wc * 32 + 8 * fq;
#pragma unroll
        for (int ai = 0; ai < 2; ++ai) {
            u32x4 xv[4][2];
#pragma unroll
            for (int m = 0; m < 4; ++m) { const bf16_t* rowp = XB + (size_t)(row0 + ai * HALF + m * 16) * ldc + col0;
#pragma unroll
                for (int bj = 0; bj < 2; ++bj) xv[m][bj] = *(const u32x4*)(rowp + bj * HALF); }
#pragma unroll
            for (int m = 0; m < 4; ++m) { const int row = row0 + ai * HALF + m * 16; bf16_t* rowp = XB + (size_t)row * ldc + col0; float q = 0.f;
#pragma unroll
                for (int bj = 0; bj < 2; ++bj) { const u32x4 x = xv[m][bj];
                    const f32x4 x0 = {__builtin_bit_cast(float, x[0] << 16), __builtin_bit_cast(float, x[0] & 0xffff0000u), __builtin_bit_cast(float, x[1] << 16), __builtin_bit_cast(float, x[1] & 0xffff0000u)};
                    const f32x4 x1 = {__builtin_bit_cast(float, x[2] << 16), __builtin_bit_cast(float, x[2] & 0xffff0000u), __builtin_bit_cast(float, x[3] << 16), __builtin_bit_cast(float, x[3] & 0xffff0000u)};
                    const f32x4 v0 = x0 + acc[ai][bj][m][0] * scale, v1 = x1 + acc[ai][bj][m][1] * scale;
                    q += ((v0[0] * v0[0] + v0[1] * v0[1]) + (v0[2] * v0[2] + v0[3] * v0[3])) + ((v1[0] * v1[0] + v1[1] * v1[1]) + (v1[2] * v1[2] + v1[3] * v1[3]));
                    u32x4 w; w.x = cvt_pk_bf16(v0[0], v0[1]); w.y = cvt_pk_bf16(v0[2], v0[3]); w.z = cvt_pk_bf16(v1[0], v1[1]); w.w = cvt_pk_bf16(v1[2], v1[3]); *(u32x4*)(rowp + bj * HALF) = w; }
                q += __shfl_xor(q, 16); q += __shfl_xor(q, 32); if (fq == 0) P[(ai * HALF + wr * 64 + m * 16 + fr) * 4 + wc] = q; }
            asm volatile("" ::: "memory"); }
        {
            asm volatile("s_waitcnt lgkmcnt(0)" ::: "memory"); __builtin_amdgcn_s_barrier(); asm volatile("" ::: "memory");
            const int lane = fr + 16 * fq, r = (wr * 4 + wc) * 32 + lane;
            if (lane < 32) { const f32x4 p = *(const PG8_LAS f32x4*)(P + r * 4); ss[(size_t)(u.pm * BM + r) * 8 + u.pn] = (p[0] + p[1]) + (p[2] + p[3]); }
        }
    }
};
struct EpiGla {
    static constexpr bool PERM = true, AFTER_DRAIN = false; static constexpr int NSTORES = 16;
    bf16_t* O; int ldc; const float* lb; const ssq_t* ss;
    typedef RsRaw Raw;
    __device__ __forceinline__ Raw issue(const Unit& u, int wid, int lane) const { return rs_issue(ss, u, wid, lane); }
    __device__ __forceinline__ void finish(const Raw& r, PG8_LAS float* rsbuf, int wid, int lane) const { rs_finish(r, rsbuf, wid, lane); }
    __device__ __forceinline__ void operator()(const f32x4 (&acc)[2][2][4][2], const Unit& u, int wr, int wc, int fr, int fq, const PG8_LAS float* rsbuf) const {
        const int row0 = u.pm * BM + wr * 64 + fr, col0 = u.pn * BM + wc * 32 + 8 * fq;
        const int sec = u.pn >> 3;
        f32x4 lbv[2][2];
#pragma unroll
        for (int bj = 0; bj < 2; ++bj)
#pragma unroll
            for (int n = 0; n < 2; ++n) lbv[bj][n] = (sec == 1) ? *(const f32x4*)(lb + (col0 - 2048) + bj * HALF + 4 * n) : (f32x4){0.f, 0.f, 0.f, 0.f};
#pragma unroll
        for (int ai = 0; ai < 2; ++ai)
#pragma unroll
            for (int m = 0; m < 4; ++m) { const int row = row0 + ai * HALF + m * 16; bf16_t* rowp = O + (size_t)row * ldc + col0; const float rs = rsbuf[ai * HALF + wr * 64 + m * 16 + fr];
#pragma unroll
                for (int bj = 0; bj < 2; ++bj) { f32x4 v[2] = {acc[ai][bj][m][0] * rs, acc[ai][bj][m][1] * rs};
                    if (sec == 0 || sec == 3) {
#pragma unroll
                        for (int n = 0; n < 2; ++n)
#pragma unroll
                            for (int j = 0; j < 4; ++j) v[n][j] = fast_silu(v[n][j]);
                    } else if (sec == 1) {
#pragma unroll
                        for (int n = 0; n < 2; ++n)
#pragma unroll
                            for (int j = 0; j < 4; ++j) { const float l = lbv[bj][n][j]; v[n][j] = 0.69314718056f * __builtin_amdgcn_logf(l + (1.0f - l) * fast_sigmoid(v[n][j])); }
                    }
                    u32x4 w; w.x = cvt_pk_bf16(v[0][0], v[0][1]); w.y = cvt_pk_bf16(v[0][2], v[0][3]); w.z = cvt_pk_bf16(v[1][0], v[1][1]); w.w = cvt_pk_bf16(v[1][2], v[1][3]);
                    *(u32x4*)(rowp + bj * HALF) = w; } }
    }
};

template <class Epi, class Sched, bool ALIGN_EPI = false, bool SP2 = false, bool TA = false, bool TB = false>
__device__ __forceinline__ void gemm_phase(PG8_LAS unsigned char* lds, const Gemm g, const Sched& S, const Epi& E) {
    int tid_ = threadIdx.x; asm volatile("" : "+v"(tid_));
    const int tid = tid_, wid = __builtin_amdgcn_readfirstlane(tid >> 6), lane = tid & 63, wr = wid >> 2, wc = wid & 3, fr = lane & 15, fq = lane >> 4;
    const int K = g.K, nt = K / BK;
    unsigned voffA[2], voffB[2];
#pragma unroll
    for (int i = 0; i < 2; ++i) { int R, C; stage_rc(tid * 16 + i * 8192, R, C); const int Rb = Epi::PERM ? ((R & ~31) + perm32(R & 31)) : R;
        voffA[i] = (unsigned)(R * (TA ? BK : g.lda) + C) * 2u; voffB[i] = (unsigned)(Rb * (TB ? BK : g.ldb) + C) * 2u; }
    const size_t kstepA = TA ? (size_t)BM * BK * 2 : (size_t)(BK * 2), kstepB = TB ? (size_t)BM * BK * 2 : (size_t)(BK * 2);
    const size_t hstepA = (size_t)HALF * (TA ? BK : g.lda) * 2, hstepB = (size_t)HALF * (TB ? BK : g.ldb) * 2;
    const size_t tstepA = TA ? (size_t)(K / BK) * BM * BK * 2 : 2 * hstepA, tstepB = TB ? (size_t)(K / BK) * BM * BK * 2 : 2 * hstepB;
    const unsigned ldsw = (unsigned)wid * 1024u;
    const int aoff = lds_byte(wr * 64 + fr, fq * 8), boff = lds_byte(wc * 32 + fr, fq * 8);
#define PG8_SA(b, h) (((b) * 2 + (h)) * HTB)
#define PG8_SB(b, h) ((4 + (b) * 2 + (h)) * HTB)
#define PG8_STAGE(bufoff, gbase, voff) do { _Pragma("unroll") for (int _i = 0; _i < 2; ++_i) \
        __builtin_amdgcn_global_load_lds((const unsigned*)((const char*)(gbase) + (voff)[_i]), (PG8_LAS unsigned*)(lds + (bufoff) + ldsw + _i * 8192), 16, 0, 0); } while (0)
#define PG8_LDA(dst, b, h) do { _Pragma("unroll") for (int m = 0; m < 4; ++m) _Pragma("unroll") for (int k = 0; k < 2; ++k) dst[m][k] = *(const PG8_LAS bf16x8*)(lds + PG8_SA(b, h) + aoff + m * 2048 + k * 1024); } while (0)
#define PG8_LDB(dst, b, h) do { _Pragma("unroll") for (int n = 0; n < 2; ++n) _Pragma("unroll") for (int k = 0; k < 2; ++k) dst[n][k] = *(const PG8_LAS bf16x8*)(lds + PG8_SB(b, h) + boff + n * 2048 + k * 1024); } while (0)
#define PG8_MMA(ai, bj, At, Bt) do { __builtin_amdgcn_s_setprio(1); _Pragma("unroll") for (int m = 0; m < 4; ++m) _Pragma("unroll") for (int n = 0; n < 2; ++n) _Pragma("unroll") for (int k = 0; k < 2; ++k) \
        acc[ai][bj][m][n] = __builtin_amdgcn_mfma_f32_16x16x32_bf16(Bt[n][k], At[m][k], acc[ai][bj][m][n], 0, 0, 0); __builtin_amdgcn_s_setprio(0); } while (0)
#define PG8_WAIT_V(n) asm volatile("s_waitcnt vmcnt(" #n ")" ::: "memory")
#define PG8_WAIT_L(n) asm volatile("s_waitcnt lgkmcnt(" #n ")" ::: "memory")
#define PG8_BAR __builtin_amdgcn_s_barrier()
#define PG8_SCHED __builtin_amdgcn_sched_barrier(0)
    Unit cur, nxt; int ui = 0;
    if (!S.next(0, cur)) return;
    f32x4 acc[2][2][4][2];
#pragma unroll
    for (int a = 0; a < 2; ++a)
#pragma unroll
        for (int b = 0; b < 2; ++b)
#pragma unroll
            for (int m = 0; m < 4; ++m)
#pragma unroll
                for (int n = 0; n < 2; ++n) acc[a][b][m][n] = (f32x4){0.f, 0.f, 0.f, 0.f};
    bf16x8 At[4][2], B0[2][2], B1[2][2];
    const char* cA = (const char*)g.A + (size_t)cur.pm * tstepA; const char* cB = (const char*)g.Bt + (size_t)cur.pn * tstepB;
    S.a_ready(cur);
    PG8_LAS float* const rs_tab = (PG8_LAS float*)(lds + STAGE_BYTES + 256 + 4096);
    int rs_par = 0; E.finish(E.issue(cur, wid, lane), rs_tab, wid, lane);
    if constexpr (SP2) {
        PG8_STAGE(PG8_SB(0, 0), cB, voffB); PG8_STAGE(PG8_SB(0, 1), cB + hstepB, voffB); PG8_STAGE(PG8_SA(0, 0), cA, voffA); PG8_STAGE(PG8_SA(0, 1), cA + hstepA, voffA);
        if (wr == 1) PG8_BAR;
        PG8_WAIT_V(2); PG8_BAR;
        PG8_STAGE(PG8_SB(1, 0), cB + kstepB, voffB); PG8_STAGE(PG8_SA(1, 0), cA + kstepA, voffA); PG8_STAGE(PG8_SB(1, 1), cB + hstepB + kstepB, voffB);
        PG8_WAIT_V(6); PG8_BAR;
    } else {
        PG8_STAGE(PG8_SB(0, 0), cB, voffB); PG8_STAGE(PG8_SA(0, 0), cA, voffA); PG8_STAGE(PG8_SB(0, 1), cB + hstepB, voffB); PG8_STAGE(PG8_SA(0, 1), cA + hstepA, voffA);
        if (wr == 1) PG8_BAR;
        PG8_WAIT_V(4); PG8_BAR;
        PG8_STAGE(PG8_SB(1, 0), cB + kstepB, voffB); PG8_STAGE(PG8_SA(1, 0), cA + kstepA, voffA); PG8_STAGE(PG8_SB(1, 1), cB + hstepB + kstepB, voffB);
        PG8_WAIT_V(6); PG8_BAR;
    }
    for (;;) {
        const bool has_next = S.next(ui + 1, nxt);
        const char* nA = has_next ? (const char*)g.A + (size_t)nxt.pm * tstepA : cA; const char* nB = has_next ? (const char*)g.Bt + (size_t)nxt.pn * tstepB : cB;
        for (int t = 0; t < nt; t += 2) {
            const bool last = (t == nt - 2);
            const char* a1 = cA + (size_t)(t + 1) * kstepA;
            const char* a2 = last ? nA : cA + (size_t)(t + 2) * kstepA; const char* b2 = last ? nB : cB + (size_t)(t + 2) * kstepB;
            const char* a3 = a2 + kstepA; const char* b3 = b2 + kstepB;
            if (last && has_next) S.a_ready(nxt);
            if constexpr (SP2) {
            PG8_LDB(B0, 0, 0); PG8_LDB(B1, 0, 1); PG8_SCHED; PG8_LDA(At, 0, 0); PG8_STAGE(PG8_SA(1, 1), a1 + hstepA, voffA);
            PG8_WAIT_V(8); PG8_WAIT_L(0); PG8_BAR; PG8_MMA(0, 0, At, B0); PG8_MMA(0, 1, At, B1); PG8_BAR; PG8_SCHED;
            PG8_LDA(At, 0, 1); PG8_STAGE(PG8_SB(0, 0), b2, voffB); PG8_STAGE(PG8_SB(0, 1), b2 + hstepB, voffB); PG8_STAGE(PG8_SA(0, 0), a2, voffA);
            PG8_WAIT_V(8); PG8_WAIT_L(0); PG8_BAR; PG8_MMA(1, 0, At, B0); PG8_MMA(1, 1, At, B1); PG8_BAR; PG8_SCHED;
            PG8_LDB(B0, 1, 0); PG8_LDB(B1, 1, 1); PG8_SCHED; PG8_LDA(At, 1, 0); PG8_STAGE(PG8_SA(0, 1), a2 + hstepA, voffA);
            PG8_WAIT_V(8); PG8_WAIT_L(0); PG8_BAR; PG8_MMA(0, 0, At, B0); PG8_MMA(0, 1, At, B1); PG8_BAR; PG8_SCHED;
            PG8_LDA(At, 1, 1); PG8_STAGE(PG8_SB(1, 0), b3, voffB); PG8_STAGE(PG8_SB(1, 1), b3 + hstepB, voffB); PG8_STAGE(PG8_SA(1, 0), a3, voffA);
            PG8_WAIT_V(8); PG8_WAIT_L(0); PG8_BAR; PG8_MMA(1, 0, At, B0); PG8_MMA(1, 1, At, B1); PG8_BAR; PG8_SCHED;
            } else {
            PG8_LDB(B0, 0, 0); PG8_SCHED; PG8_LDA(At, 0, 0); PG8_STAGE(PG8_SA(1, 1), a1 + hstepA, voffA);
            PG8_WAIT_L(8); PG8_BAR; PG8_WAIT_L(0); PG8_MMA(0, 0, At, B0); PG8_BAR; PG8_SCHED;
            PG8_LDB(B1, 0, 1); PG8_STAGE(PG8_SB(0, 0), b2, voffB);
            PG8_BAR; PG8_WAIT_L(0); PG8_MMA(0, 1, At, B1); PG8_BAR;
            PG8_LDA(At, 0, 1); PG8_STAGE(PG8_SA(0, 0), a2, voffA);
            PG8_BAR; PG8_WAIT_L(0); PG8_MMA(1, 0, At, B0); PG8_BAR; PG8_SCHED;
            PG8_STAGE(PG8_SB(0, 1), b2 + hstepB, voffB);
            PG8_WAIT_V(6); PG8_BAR; PG8_MMA(1, 1, At, B1); PG8_BAR;
            PG8_LDB(B0, 1, 0); PG8_SCHED; PG8_LDA(At, 1, 0); PG8_STAGE(PG8_SA(0, 1), a2 + hstepA, voffA);
            PG8_WAIT_L(8); PG8_BAR; PG8_WAIT_L(0); PG8_MMA(0, 0, At, B0); PG8_BAR; PG8_SCHED;
            PG8_LDB(B1, 1, 1); PG8_STAGE(PG8_SB(1, 0), b3, voffB);
            PG8_BAR; PG8_WAIT_L(0); PG8_MMA(0, 1, At, B1); PG8_BAR;
            PG8_LDA(At, 1, 1); PG8_STAGE(PG8_SA(1, 0), a3, voffA);
            PG8_BAR; PG8_WAIT_L(0); PG8_MMA(1, 0, At, B0); PG8_BAR; PG8_SCHED;
            PG8_STAGE(PG8_SB(1, 1), b3 + hstepB, voffB);
            PG8_WAIT_V(6); PG8_BAR; PG8_MMA(1, 1, At, B1); PG8_BAR;
            }
        }
        if constexpr (ALIGN_EPI) { if (wr == 0) PG8_BAR; }
        if constexpr (!Epi::AFTER_DRAIN) { typename Epi::Raw raw = E.issue(has_next ? nxt : cur, wid, lane); E(acc, cur, wr, wc, fr, fq, rs_tab + rs_par * 256); rs_par ^= 1; E.finish(raw, rs_tab + rs_par * 256, wid, lane); S.done(cur); }
        if (!has_next) break;
#pragma unroll
        for (int a = 0; a < 2; ++a)
#pragma unroll
            for (int b = 0; b < 2; ++b)
#pragma unroll
                for (int m = 0; m < 4; ++m)
#pragma unroll
                    for (int n = 0; n < 2; ++n) acc[a][b][m][n] = (f32x4){0.f, 0.f, 0.f, 0.f};
        cur = nxt; cA = nA; cB = nB; ++ui;
        if constexpr (ALIGN_EPI) { if (wr == 1) PG8_BAR; }
    }
    PG8_WAIT_V(0);
    if constexpr (!ALIGN_EPI) { if (wr == 0) PG8_BAR; }
    PG8_BAR;
#undef PG8_SA
#undef PG8_SB
#undef PG8_STAGE
#undef PG8_LDA
#undef PG8_LDB
#undef PG8_MMA
#undef PG8_WAIT_V
#undef PG8_WAIT_L
#undef PG8_BAR
#undef PG8_SCHED
}
}
constexpr int D = 2048, DFF = 5632, NB = 16, SEQ = 2048, DB = 8, DSEQ = 64, PAST = 4096, DEPTH = 4;
constexpr int MP = NB * SEQ, MS = DB * DSEQ, M = MP + MS;
constexpr int KVS = PAST + DSEQ;
constexpr int KVROWS = MP + DB * KVS;
constexpr int DCONV = 1024, QL = 512, KVL = 512, ROPE = 64, NOPE = 128, VD = 128, HEADS = 8, QHD = NOPE + ROPE;
constexpr int DINA = 3 * DCONV + QL + KVL + ROPE, DINA_P = 4352, DINC = 8192, HGH = 16, HGD = 128;
constexpr float EPS = 1e-6f;
static_assert(M % 256 == 0 && KVROWS % 256 == 0 && DINA == 4160, "shapes");
constexpr size_t O_YP = 0, O_YS = O_YP + (size_t)MP * D, O_CONVP = O_YS + (size_t)MS * D, O_CKVP = O_CONVP + (size_t)2 * NB * 2 * DCONV, O_KPEP = O_CKVP + (size_t)2 * NB * SEQ * KVL,
                 O_HGP = O_KPEP + (size_t)2 * NB * SEQ * ROPE, O_CONVS = O_HGP + (size_t)2 * NB * HGH * HGD * HGD, O_CKVS = O_CONVS + (size_t)2 * DB * 2 * DCONV,
                 O_KPES = O_CKVS + (size_t)2 * DB * DSEQ * KVL, O_HGS = O_KPES + (size_t)2 * DB * DSEQ * ROPE, O_END = O_HGS + (size_t)2 * DB * HGH * HGD * HGD;
static_assert(O_END == 119177216, "output size");
enum { I_XP = 0, I_XS, I_CCONV, I_CCKV, I_CKPE, I_SHG, I_NF1, I_F1G, I_F1U, I_F1D, I_NMIX, I_WINA, I_WCONV, I_GQ, I_WUQ, I_GKV, I_WUKV, I_WOA, I_WINC, I_LB, I_GO, I_WOC, I_NF2, I_F2G, I_F2U, I_F2D, I_NFIN, N_IN };

constexpr size_t MiB = 1u << 20;
constexpr size_t WS_CTL = 0, CTL_ZERO_BYTES = 1 * MiB;
constexpr size_t WS_ROPE = 4 * MiB;
constexpr size_t WS_LB = 5 * MiB + 512 * 1024;
constexpr size_t WS_WGU = 6 * MiB;
constexpr size_t WS_WD = WS_WGU + 8 * 44 * MiB;
constexpr size_t WS_WINA = WS_WD + 8 * 22 * MiB;
constexpr size_t WS_WINC = WS_WINA + 2 * 17 * MiB;
constexpr size_t WS_WUQ = WS_WINC + 2 * 32 * MiB;
constexpr size_t WS_WUKV = WS_WUQ + 3 * MiB;
constexpr size_t WS_WOA = WS_WUKV + 4 * MiB;
constexpr size_t WS_WOC = WS_WOA + 16 * MiB;
constexpr size_t WS_XN = WS_WOC + 16 * MiB;
constexpr size_t WS_CAT = WS_XN + 130 * MiB;
constexpr size_t WS_BIG = WS_CAT + 130 * MiB;
constexpr size_t WS_H = WS_BIG;
constexpr size_t WS_ZC = WS_BIG;
constexpr size_t WS_CQN = WS_BIG;
constexpr size_t WS_KVIN = WS_BIG + 33 * MiB;
constexpr size_t WS_KPEB = WS_BIG + 98 * MiB;
constexpr size_t WS_ZA = WS_BIG + 107 * MiB;
constexpr size_t WS_QB = WS_BIG + 107 * MiB;
constexpr size_t WS_KNOPE = WS_BIG + 205 * MiB;
constexpr size_t WS_VT = WS_BIG + 384 * MiB;
constexpr size_t WS_END = WS_BIG + 520 * MiB;
constexpr size_t WS_SS = WS_END;
constexpr size_t WS_SS_BYTES = (size_t)13 * M * 8 * 4, WS_TOTAL = WS_END + 14 * MiB;
static_assert(WS_END + WS_SS_BYTES <= WS_TOTAL, "ss map");
static_assert(WS_ZA + (size_t)M * DINA_P * 2 <= WS_VT && WS_KNOPE + (size_t)KVROWS * 1024 * 2 <= WS_VT && WS_QB + (size_t)M * 1536 * 2 <= WS_KNOPE && WS_VT + (size_t)1024 * KVROWS * 2 <= WS_END, "even-layer map");
static_assert(WS_CQN + (size_t)M * 512 * 2 <= WS_KVIN && WS_KVIN + (size_t)KVROWS * 512 * 2 <= WS_KPEB && WS_KPEB + (size_t)KVROWS * 64 * 2 <= WS_ZA, "even-layer map 2");
static_assert(WS_ZC + (size_t)M * DINC * 2 <= WS_END && WS_H + (size_t)M * DFF * 2 <= WS_END, "odd/ffn map");
static_assert(WS_ROPE + (size_t)KVS * 64 * 4 <= WS_LB && WS_LB + 2 * 2048 * 4 <= WS_WGU, "ctl map");
constexpr int CW_BAR = 4096;
constexpr int CW_ATTN = 8192;
constexpr int CW_GLA = 8192 + 256;
constexpr int CW_CONV = 8192 + 512;

constexpr int RING_OFF = 0, RING_BYTES = 131072;
constexpr int MISC_OFF = RING_BYTES;
constexpr int EPI_P_OFF = RING_BYTES + 256;
constexpr int LDS_BYTES = 147456;
constexpr int NWAVES = 8, NTHR = 512;

#define GAS __attribute__((address_space(1)))
#define CAS __attribute__((address_space(4)))
#define LAS __attribute__((address_space(3)))
typedef unsigned short bf16;
typedef unsigned v4u __attribute__((ext_vector_type(4)));
typedef unsigned v2u __attribute__((ext_vector_type(2)));
typedef float f32x4 __attribute__((ext_vector_type(4)));
typedef short bf16x8 __attribute__((ext_vector_type(8)));
#define LDS_WAIT() asm volatile("s_waitcnt lgkmcnt(0)" ::: "memory")
#define VM_WAIT() asm volatile("s_waitcnt vmcnt(0)" ::: "memory")
__device__ __forceinline__ unsigned f2bf(float f) { unsigned u = __builtin_bit_cast(unsigned, f); return (u + 0x7fffu + ((u >> 16) & 1u)) >> 16; }
__device__ __forceinline__ unsigned pk2(float lo, float hi) { return f2bf(lo) | (f2bf(hi) << 16); }
__device__ __forceinline__ float bf2f(unsigned b) { return __builtin_bit_cast(float, b << 16); }
__device__ __forceinline__ float bflo(unsigned w) { return __builtin_bit_cast(float, w << 16); }
__device__ __forceinline__ float bfhi(unsigned w) { return __builtin_bit_cast(float, w & 0xffff0000u); }
__device__ __forceinline__ float wave_sum(float v) {
#pragma unroll
    for (int o = 1; o < 64; o <<= 1) v += __shfl_xor(v, o);
    return v;
}
#define XB_TMO      128
#define XB_XCNT(j)  (256  + 64 * (j))
#define XB_XSUB(j)  (1280 + 64 * (j))
#define XB_XGEN(j)  (2304 + 64 * (j))
#define XB_TOP      3328
#define XB_TOPGEN   3392
#define XCD_BAR_WORDS 3456
#define XB_SPIN_CAP (1u << 18)

__device__ __forceinline__ unsigned xb_ld(unsigned* p)              { return __hip_atomic_load(p, __ATOMIC_RELAXED, __HIP_MEMORY_SCOPE_AGENT); }
__device__ __forceinline__ unsigned xb_add(unsigned* p, unsigned v) { return __hip_atomic_fetch_add(p, v, __ATOMIC_RELAXED, __HIP_MEMORY_SCOPE_AGENT); }
__device__ __forceinline__ unsigned xb_xcc_id() { return (unsigned)__builtin_amdgcn_s_getreg((3 << 11) | 20) & 0xFu; }
#define XB_SPIN(cond, bar) do { unsigned _sp = 0; while (cond) { __builtin_amdgcn_s_sleep(1); \
    if ((++_sp & 255u) == 0u) { if (xb_ld(&(bar)[XB_TMO])) break; if (_sp > XB_SPIN_CAP) { atomicAdd(&(bar)[XB_TMO], 1u); break; } } } } while (0)

struct XcdBarrier {
    unsigned* bar; unsigned x;
    volatile LAS unsigned* st;
};

__device__ __forceinline__ XcdBarrier xcd_barrier_post(unsigned* bar, volatile LAS unsigned* st) {
    XcdBarrier b; b.bar = bar; b.x = xb_xcc_id(); b.st = st;
    if (threadIdx.x == 0) (void)xb_add(&bar[XB_XCNT(b.x)], 1u);
    return b;
}
__device__ __forceinline__ void xcd_barrier_complete(unsigned* bar, unsigned x, unsigned& nloc, unsigned& nx) {
    const unsigned G = gridDim.x * gridDim.y * gridDim.z;
    unsigned sum, cnt, mine, sp = 0u;
    for (;;) {
        sum = 0u; cnt = 0u; mine = 0u;
#pragma unroll
        for (unsigned j = 0; j < 16; ++j) { const unsigned c = xb_ld(&bar[XB_XCNT(j)]); sum += c; cnt += (c > 0u) ? 1u : 0u; mine = (j == x) ? c : mine; }
        if (sum == G) break;
        __builtin_amdgcn_s_sleep(1);
        if ((++sp & 255u) == 0u) { if (xb_ld(&bar[XB_TMO])) break; if (sp > XB_SPIN_CAP) { atomicAdd(&bar[XB_TMO], 1u); break; } }
    }
    nloc = mine > 0u ? mine : 1u; nx = cnt > 0u ? cnt : 1u;
}

__device__ __forceinline__ void xcd_barrier(const XcdBarrier& b) {
    asm volatile("s_waitcnt vmcnt(0)" ::: "memory");
    __syncthreads();
    if (threadIdx.x == 0) {
        unsigned* bar = b.bar;
        __builtin_amdgcn_s_waitcnt(0);
        unsigned nloc = b.st[0], nx = b.st[1];
        if (nloc == 0u) { xcd_barrier_complete(bar, b.x, nloc, nx); b.st[0] = nloc; b.st[1] = nx; }
        const unsigned old = xb_add(&bar[XB_XSUB(b.x)], 1u);
        const unsigned gen = old / nloc;
        if (old + 1u == (gen + 1u) * nloc) {
            __builtin_amdgcn_fence(__ATOMIC_RELEASE, "agent");
            asm volatile("s_waitcnt vmcnt(0)" ::: "memory");
            const unsigned og = xb_add(&bar[XB_TOP], 1u);
            const unsigned tg = og / nx;
            if (og + 1u == (tg + 1u) * nx) xb_add(&bar[XB_TOPGEN], 1u);
            else XB_SPIN(xb_ld(&bar[XB_TOPGEN]) == tg, bar);
            __builtin_amdgcn_fence(__ATOMIC_ACQUIRE, "agent");
            xb_add(&bar[XB_XGEN(b.x)], 1u);
            asm volatile("s_waitcnt vmcnt(0)" ::: "memory");
        } else {
            XB_SPIN(xb_ld(&bar[XB_XGEN(b.x)]) == gen, bar);
            __builtin_amdgcn_fence(__ATOMIC_ACQUIRE, "agent");
            asm volatile("s_waitcnt vmcnt(0)" ::: "memory");
        }
    }
    __syncthreads();
}


struct Args { const float* in[N_IN]; float* out; unsigned char* ws; int ph_lo, ph_hi; };
static_assert(sizeof(Args) == (N_IN + 2) * 8 + 8, "Args has no padding");

constexpr int CV_ROWP = 144;
__device__ __forceinline__ void cv_tile(const float* W, int N, bf16* WT, int ldt, int dst_row0, LAS unsigned char* scr, int k0, int n0, int lane, const float* gain) {
    const int c4 = lane & 15, kq = lane >> 4;
#pragma unroll 4
    for (int i = 0; i < 16; ++i) { const int kk = 4 * i + kq; const f32x4 v = *(const GAS f32x4*)(W + (size_t)(k0 + kk) * N + n0 + 4 * c4); const float gk = gain ? gain[k0 + kk] : 1.0f;
        LAS unsigned char* p = scr + (4 * c4) * CV_ROWP + kk * 2;
        *(LAS unsigned short*)(p) = (unsigned short)f2bf(v.x * gk); *(LAS unsigned short*)(p + CV_ROWP) = (unsigned short)f2bf(v.y * gk);
        *(LAS unsigned short*)(p + 2 * CV_ROWP) = (unsigned short)f2bf(v.z * gk); *(LAS unsigned short*)(p + 3 * CV_ROWP) = (unsigned short)f2bf(v.w * gk); }
    LDS_WAIT(); asm volatile("" ::: "memory");
    const int c = lane & 7, nr = lane >> 3;
#pragma unroll
    for (int j = 0; j < 8; ++j) { const int n = nr + 8 * j; const v4u o = *(const LAS v4u*)(scr + n * CV_ROWP + c * 16);
        *(GAS v4u*)(WT + (size_t)(dst_row0 + n) * ldt + k0 + 8 * c) = o; }
    LDS_WAIT(); asm volatile("" ::: "memory");
}
constexpr int CV_FFN = 2816, CV_INA = 32 * 65, CV_INC = 32 * 128, CV_UQ = 8 * 24, CV_UKV = 8 * 32, CV_O = 32 * 32;
__device__ __forceinline__ void cv_ffn_item(const float* const CAS* in, unsigned char* ws, int f, int l, int r, LAS unsigned char* scr, int lane) {
    const int type = r / CV_FFN, item = r % CV_FFN, inst = f * 4 + l;
    if (type < 2) { const float* src = in[f ? (type ? I_F2U : I_F2G) : (type ? I_F1U : I_F1G)] + (size_t)l * D * DFF; const int kb = item / 88, nb = item % 88, n0 = 64 * nb;
        cv_tile(src, DFF, (bf16*)(ws + WS_WGU) + (size_t)inst * 2 * DFF * D, D, 256 * (n0 >> 7) + (n0 & 127) + (type ? 128 : 0), scr, 64 * kb, n0, lane, in[f ? I_NF2 : I_NF1] + l * D); }
    else { const float* src = in[f ? I_F2D : I_F1D] + (size_t)l * DFF * D; const int kb = item >> 5, nb = item & 31;
        bf16* tb = (bf16*)(ws + WS_WD) + (size_t)inst * D * DFF + ((size_t)((nb >> 2) * (DFF / 64) + kb) * 256 + 64 * (nb & 3)) * 64;
        cv_tile(src, D, tb - 64 * kb, 64, 0, scr, 64 * kb, 64 * nb, lane, nullptr); }
}
__device__ __forceinline__ int cv_group_items(int g) { if (g == 0 || (g & 1) == 0) return 3 * CV_FFN; const int l = (g - 1) >> 1; return ((l & 1) ? CV_INC + CV_O : CV_INA + CV_UQ + CV_UKV + CV_O) + 3 * CV_FFN; }
__device__ __forceinline__ void cv_group_item(const float* const CAS* in, unsigned char* ws, int g, int r, LAS unsigned char* scr, int lane) {
    if (g == 0) { cv_ffn_item(in, ws, 0, 0, r, scr, lane); return; }
    if ((g & 1) == 0) { cv_ffn_item(in, ws, 0, g >> 1, r, scr, lane); return; }
    const int l = (g - 1) >> 1, e = l >> 1;
    if (l & 1) {
        if (r < CV_INC) { const int kb = r >> 7, nb = r & 127; cv_tile(in[I_WINC] + (size_t)e * D * DINC, DINC, (bf16*)(ws + WS_WINC) + (size_t)e * DINC * D, D, 64 * nb, scr, 64 * kb, 64 * nb, lane, in[I_NMIX] + l * D); return; } r -= CV_INC;
        if (r < CV_O) { const int kb = r >> 5, nb = r & 31; cv_tile(in[I_WOC] + (size_t)e * D * D, D, (bf16*)(ws + WS_WOC) + (size_t)e * D * D, D, 64 * nb, scr, 64 * kb, 64 * nb, lane, nullptr); return; } r -= CV_O;
    } else {
        if (r < CV_INA) { const int kb = r / 65, nb = r % 65; cv_tile(in[I_WINA] + (size_t)e * D * DINA, DINA, (bf16*)(ws + WS_WINA) + (size_t)e * DINA_P * D, D, 64 * nb, scr, 64 * kb, 64 * nb, lane, in[I_NMIX] + l * D); return; } r -= CV_INA;
        if (r < CV_UQ) { const int kb = r / 24, nb = r % 24; cv_tile(in[I_WUQ] + (size_t)e * QL * 1536, 1536, (bf16*)(ws + WS_WUQ) + (size_t)e * 1536 * QL, QL, 64 * nb, scr, 64 * kb, 64 * nb, lane, nullptr); return; } r -= CV_UQ;
        if (r < CV_UKV) { const int kb = r >> 5, nb = r & 31, n0 = 64 * nb, hh = n0 >> 8, rr = n0 & 255;
            cv_tile(in[I_WUKV] + (size_t)e * KVL * 2048, 2048, (bf16*)(ws + WS_WUKV) + (size_t)e * 2048 * KVL, KVL, (rr < 128 ? 0 : 1024) + hh * 128 + (rr & 127), scr, 64 * kb, n0, lane, nullptr); return; } r -= CV_UKV;
        if (r < CV_O) { const int kb = r >> 5, nb = r & 31; cv_tile(in[I_WOA] + (size_t)e * D * D, D, (bf16*)(ws + WS_WOA) + (size_t)e * D * D, D, 64 * nb, scr, 64 * kb, 64 * nb, lane, nullptr); return; } r -= CV_O;
    }
    cv_ffn_item(in, ws, 1, l, r, scr, lane);
}
__device__ __forceinline__ void cv_group(const float* const CAS* in, unsigned char* ws, int g, unsigned* ctr, LAS unsigned char* scr, int lane, int part = 0) {
    const int nall = cv_group_items(g), lo = part == 2 ? nall - 2 * CV_FFN : 0, n = part == 1 ? nall - 2 * CV_FFN : nall;
    for (;;) { unsigned base = 0; if (lane == 0) base = atomicAdd(ctr, 4u); base = (unsigned)__builtin_amdgcn_readfirstlane((int)base); const int b0 = lo + (int)base;
        if (b0 >= n) break;
        for (int j = 0; j < 4; ++j) if (b0 + j < n) cv_group_item(in, ws, g, b0 + j, scr, lane); }
}
__device__ __forceinline__ void x_row_init(const float* xin, bf16* brow, pg8::ssq_t* ss, int lane) {
    const GAS f32x4* xr = (const GAS f32x4*)xin + lane; GAS v2u* o8 = (GAS v2u*)brow + lane;
    float s = 0.f;
#pragma unroll
    for (int j = 0; j < 8; ++j) { const f32x4 v = xr[64 * j]; s += (v.x * v.x + v.y * v.y) + (v.z * v.z + v.w * v.w); v2u w; w.x = pk2(v.x, v.y); w.y = pk2(v.z, v.w); o8[64 * j] = w; }
    s = wave_sum(s);
    if (lane < 8) ss[lane] = lane == 0 ? s : 0.f;
}

namespace att {
constexpr int KROW = 400, VROW = 144;
constexpr int KBYTES = 64 * KROW, VBYTES = 128 * VROW, BUF = KBYTES + VBYTES;
constexpr int UNIT_OFF = 2 * BUF;
constexpr int NUNITS = DB * HEADS + NB * HEADS * 8;
constexpr float SC_LOG2E = 0.07216878364870322f * 1.44269504088896f;
static_assert(UNIT_OFF + 64 <= RING_BYTES, "attention LDS");

struct Stage { v4u kn[2]; v4u kp; v4u vt[2]; };

__device__ __forceinline__ void stage_load(Stage& s, const bf16* KN, const bf16* KP, const bf16* VTp, int kvrow, int h, int tid) {
    const GAS bf16* kn = (const GAS bf16*)(KN + (size_t)kvrow * 1024 + h * 128); const GAS bf16* kp = (const GAS bf16*)(KP + (size_t)kvrow * 64); const GAS bf16* vt = (const GAS bf16*)(VTp + (size_t)h * 128 * KVROWS + kvrow);
#pragma unroll
    for (int i = 0; i < 2; ++i) { const unsigned p = tid + 512 * i, off = (p >> 4) * 1024u + 8u * (p & 15); s.kn[i] = *(const GAS v4u*)(kn + off); }
    { const unsigned off = (unsigned)(tid >> 3) * 64u + 8u * (tid & 7); s.kp = *(const GAS v4u*)(kp + off); }
#pragma unroll
    for (int i = 0; i < 2; ++i) { const unsigned p = tid + 512 * i, off = (p >> 3) * (unsigned)KVROWS + 8u * (p & 7); s.vt[i] = *(const GAS v4u*)(vt + off); }
}
__device__ __forceinline__ void stage_store(const Stage& s, LAS unsigned char* buf, int tid) {
#pragma unroll
    for (int i = 0; i < 2; ++i) { const int p = tid + 512 * i, key = p >> 4, c = p & 15; *(LAS v4u*)(buf + key * KROW + c * 16) = s.kn[i]; }
    { const int key = tid >> 3, c = tid & 7; *(LAS v4u*)(buf + key * KROW + 256 + c * 16) = s.kp; }
#pragma unroll
    for (int i = 0; i < 2; ++i) { const int p = tid + 512 * i, dv = p >> 3, c = p & 7; *(LAS v4u*)(buf + KBYTES + dv * VROW + c * 16) = s.vt[i]; }
}

template <bool two>
__device__ __forceinline__ void attn_unit(int unit, LAS unsigned char* lds, const bf16* QB, const bf16* KN, const bf16* KP, const bf16* VTp, const float* rope, bf16* CAT, int tid, int wave, int lane) {
    const int fr = lane & 15, fq = lane >> 4;
    int h, qrow0, kvrow0, ntiles, wlimit, pos0; bool active;
    if constexpr (!two) { const int b = unit >> 3; h = unit & 7; qrow0 = MP + b * DSEQ; kvrow0 = MP + b * KVS; ntiles = KVS / 64; wlimit = ntiles; pos0 = PAST; active = wave < 4; }
    else { const int v = unit - DB * HEADS, qt = 7 - (v >> 7), bh = v & 127, b = bh >> 3; h = bh & 7; qrow0 = b * SEQ + 256 * qt; kvrow0 = b * SEQ; ntiles = 4 * qt + 4; wlimit = 4 * qt + (wave >> 1) + 1; pos0 = 256 * qt; active = true; }
    constexpr int rpw = two ? 32 : 16;
    bf16x8 q[2][6];
#pragma unroll
    for (int ks = 0; ks < 6; ++ks) q[1][ks] = (bf16x8){0, 0, 0, 0, 0, 0, 0, 0};
    if (active) {
#pragma unroll
        for (int rg = 0; rg < (two ? 2 : 1); ++rg) { const int rr = rpw * wave + 16 * rg + fr; const bf16* qp = QB + (size_t)(qrow0 + rr) * 1536 + h * QHD + 8 * fq;
#pragma unroll
            for (int ks = 0; ks < 6; ++ks) q[rg][ks] = *(const GAS bf16x8*)(qp + 32 * ks);
            const float* rp = rope + (size_t)(pos0 + rr) * 64 + 16 * fq;
#pragma unroll
            for (int j = 0; j < 8; ++j) { const float c = rp[2 * j], s = rp[2 * j + 1]; const float x1 = bf2f((unsigned short)q[rg][4][j]), x2 = bf2f((unsigned short)q[rg][5][j]);
                q[rg][4][j] = (short)f2bf(x1 * c - x2 * s); q[rg][5][j] = (short)f2bf(x1 * s + x2 * c); } }
    } else {
#pragma unroll
        for (int rg = 0; rg < 2; ++rg)
#pragma unroll
            for (int ks = 0; ks < 6; ++ks) q[rg][ks] = (bf16x8){0, 0, 0, 0, 0, 0, 0, 0};
    }
    f32x4 o[2][8]; float mrow[2], lrow[2];
#pragma unroll
    for (int rg = 0; rg < 2; ++rg) { mrow[rg] = -1e30f; lrow[rg] = 0.f;
#pragma unroll
        for (int n = 0; n < 8; ++n) o[rg][n] = (f32x4){0.f, 0.f, 0.f, 0.f}; }
    Stage st;
    stage_load(st, KN, KP, VTp, kvrow0, h, tid);
    stage_store(st, lds, tid);
    LDS_WAIT(); __syncthreads();
    for (int kt = 0; kt < ntiles; ++kt) {
        LAS unsigned char* cur = lds + (kt & 1) * BUF; LAS unsigned char* nxt = lds + ((kt + 1) & 1) * BUF;
        const bool more = kt + 1 < ntiles;
        if (more) stage_load(st, KN, KP, VTp, kvrow0 + 64 * (kt + 1), h, tid);
        if (active && kt < wlimit) {
            f32x4 s[2][4];
#pragma unroll
            for (int rg = 0; rg < 2; ++rg)
#pragma unroll
                for (int kk = 0; kk < 4; ++kk) s[rg][kk] = (f32x4){0.f, 0.f, 0.f, 0.f};
#pragma unroll
            for (int ks = 0; ks < 6; ++ks) {
                bf16x8 kf[4];
#pragma unroll
                for (int kk = 0; kk < 4; ++kk) kf[kk] = *(const LAS bf16x8*)(cur + (16 * kk + fr) * KROW + ks * 64 + fq * 16);
#pragma unroll
                for (int kk = 0; kk < 4; ++kk) {
                    s[0][kk] = __builtin_amdgcn_mfma_f32_16x16x32_bf16(kf[kk], q[0][ks], s[0][kk], 0, 0, 0);
                    if constexpr (two) s[1][kk] = __builtin_amdgcn_mfma_f32_16x16x32_bf16(kf[kk], q[1][ks], s[1][kk], 0, 0, 0); }
            }
            bf16x8 pb[2][2];
#pragma unroll
            for (int rg = 0; rg < (two ? 2 : 1); ++rg) {
                float mx = -1e30f;
#pragma unroll
                for (int kk = 0; kk < 4; ++kk) { s[rg][kk] = s[rg][kk] * SC_LOG2E; mx = fmaxf(mx, fmaxf(fmaxf(s[rg][kk][0], s[rg][kk][1]), fmaxf(s[rg][kk][2], s[rg][kk][3]))); }
                mx = fmaxf(mx, __shfl_xor(mx, 16)); mx = fmaxf(mx, __shfl_xor(mx, 32));
                const float mnew = fmaxf(mrow[rg], mx), alpha = __builtin_amdgcn_exp2f(mrow[rg] - mnew); mrow[rg] = mnew;
                float ps = 0.f;
#pragma unroll
                for (int kk = 0; kk < 4; ++kk)
#pragma unroll
                    for (int j = 0; j < 4; ++j) { const float p = __builtin_amdgcn_exp2f(s[rg][kk][j] - mnew); s[rg][kk][j] = p; ps += p; }
                lrow[rg] = lrow[rg] * alpha + ps;
#pragma unroll
                for (int n = 0; n < 8; ++n) o[rg][n] = o[rg][n] * alpha;
#pragma unroll
                for (int k2 = 0; k2 < 2; ++k2) { v4u w; w.x = pg8::cvt_pk_bf16(s[rg][2 * k2][0], s[rg][2 * k2][1]); w.y = pg8::cvt_pk_bf16(s[rg][2 * k2][2], s[rg][2 * k2][3]);
                    w.z = pg8::cvt_pk_bf16(s[rg][2 * k2 + 1][0], s[rg][2 * k2 + 1][1]); w.w = pg8::cvt_pk_bf16(s[rg][2 * k2 + 1][2], s[rg][2 * k2 + 1][3]); pb[rg][k2] = __builtin_bit_cast(bf16x8, w); }
            }
            if constexpr (!two) { pb[1][0] = (bf16x8){0, 0, 0, 0, 0, 0, 0, 0}; pb[1][1] = (bf16x8){0, 0, 0, 0, 0, 0, 0, 0}; }
            const LAS unsigned char* vb = cur + KBYTES;
#pragma unroll
            for (int n = 0; n < 8; ++n) {
                v2u vr[2][2];
#pragma unroll
                for (int k2 = 0; k2 < 2; ++k2) { const LAS unsigned char* vp = vb + (16 * n + fr) * VROW + k2 * 64 + fq * 8; vr[k2][0] = *(const LAS v2u*)vp; vr[k2][1] = *(const LAS v2u*)(vp + 32); }
#pragma unroll
                for (int k2 = 0; k2 < 2; ++k2) { const v4u w = {vr[k2][0].x, vr[k2][0].y, vr[k2][1].x, vr[k2][1].y}; const bf16x8 vf = __builtin_bit_cast(bf16x8, w);
                    o[0][n] = __builtin_amdgcn_mfma_f32_16x16x32_bf16(vf, pb[0][k2], o[0][n], 0, 0, 0);
                    if constexpr (two) o[1][n] = __builtin_amdgcn_mfma_f32_16x16x32_bf16(vf, pb[1][k2], o[1][n], 0, 0, 0); }
            }
        }
        if (more) stage_store(st, nxt, tid);
        LDS_WAIT(); __syncthreads();
    }
    if (active) {
#pragma unroll
        for (int rg = 0; rg < (two ? 2 : 1); ++rg) { float l = lrow[rg]; l += __shfl_xor(l, 16); l += __shfl_xor(l, 32); const float inv = 1.0f / l;
            bf16* op = CAT + (size_t)(qrow0 + rpw * wave + 16 * rg + fr) * D + DCONV + h * VD + 4 * fq;
#pragma unroll
            for (int n = 0; n < 8; ++n) { v2u w; w.x = pg8::cvt_pk_bf16(o[rg][n][0] * inv, o[rg][n][1] * inv); w.y = pg8::cvt_pk_bf16(o[rg][n][2] * inv, o[rg][n][3] * inv); *(GAS v2u*)(op + 16 * n) = w; } }
    }
}
}

namespace gla {
#define WG_SYNC() do { asm volatile("s_waitcnt lgkmcnt(0)" ::: "memory"); __builtin_amdgcn_s_barrier(); asm volatile("" ::: "memory"); } while (0)
constexpr int ROWD = 272, ROWT = 144;
constexpr int KEND = 0, QT = KEND + 64 * ROWD, QJ = QT + 64 * ROWD, KLT = QJ + 160 * ROWD, VT = KLT + 128 * ROWT, SC = VT + 128 * ROWT, TOT = SC + 64 * ROWT, EAL = TOT + 2048, SSQ = EAL + 512, UNIT = SSQ + 2048, END = UNIT + 64;
static_assert(END <= RING_BYTES, "gla LDS");
constexpr int NUNITS = NB * HGH + DB * HGH;

__device__ __forceinline__ void load_raw(unsigned (&rq)[16], unsigned (&rg)[16], unsigned (&rv)[16], const bf16* zrow, int d) {
#pragma unroll
    for (int r = 0; r < 16; ++r) { const GAS bf16* p = (const GAS bf16*)(zrow + (size_t)r * DINC + d); rq[r] = p[0]; rg[r] = p[2048]; rv[r] = p[4096]; }
}

__device__ __forceinline__ void gla_unit(int unit, LAS unsigned char* lds, const bf16* ZC, const float* S0all  , const float* g_o, bf16* OB, float* hg_p  , float* hg_s  , int tid, int wave, int lane) {
    const int fr = lane & 15, fq = lane >> 4, d = tid & 127, sb = tid >> 7;
    const bool smp = unit >= NB * HGH;
    const int u2 = smp ? unit - NB * HGH : unit, b = u2 >> 4, h = u2 & 15;
    const int nch = smp ? 1 : SEQ / 64, row0 = smp ? MP + b * DSEQ : b * SEQ;
    float* sout = smp ? hg_s + ((size_t)(b * HGH + h) << 14) : hg_p + ((size_t)(b * HGH + h) << 14);
    f32x4 S[8];
    if (smp) { const float* s0 = S0all + ((size_t)(b * HGH + h) << 14) + 16 * wave + fr;
#pragma unroll
        for (int a = 0; a < 8; ++a)
#pragma unroll
            for (int e = 0; e < 4; ++e) S[a][e] = s0[(16 * a + 4 * fq + e) * 128]; }
    else {
#pragma unroll
        for (int a = 0; a < 8; ++a) S[a] = (f32x4){0.f, 0.f, 0.f, 0.f}; }
    float gov[4];
#pragma unroll
    for (int e = 0; e < 4; ++e) gov[e] = g_o[16 * wave + 4 * fq + e];
    unsigned rq[16], rg[16], rv[16];
    load_raw(rq, rg, rv, ZC + (size_t)(row0 + 16 * sb) * DINC + h * 128, d);
    LAS float* tot = (LAS float*)(lds + TOT); LAS float* eal = (LAS float*)(lds + EAL); LAS float* ssq = (LAS float*)(lds + SSQ);
    for (int c = 0; c < nch; ++c) {
        float fx[16], e1[16], bk[16];
        { float run = 0.f;
#pragma unroll
          for (int r = 0; r < 16; ++r) { const float g = bf2f(rg[r]); run += g; fx[r] = __builtin_amdgcn_exp2f(g * 1.44269504089f); }
          tot[sb * 128 + d] = run; }
        e1[0] = fx[0]; bk[15] = 1.0f;
#pragma unroll
        for (int r = 1; r < 16; ++r) { e1[r] = e1[r - 1] * fx[r]; bk[15 - r] = bk[16 - r] * fx[16 - r]; }
        WG_SYNC();
        float P[5]; P[0] = 0.f;
#pragma unroll
        for (int j = 0; j < 4; ++j) P[j + 1] = P[j] + tot[j * 128 + d];
        float Pi = 0.f, Pi1 = 0.f;
#pragma unroll
        for (int j = 0; j < 4; ++j) if (j == sb) { Pi = P[j]; Pi1 = P[j + 1]; }
        const float alast = P[4];
        const float e_tail = __expf(alast - Pi1);
        const float e_head = __expf(Pi);
        float Fj[3];
#pragma unroll
        for (int j = 0; j < 3; ++j) Fj[j] = __expf(Pi - P[j + 1]);
        if (sb == 0) eal[d] = __expf(alast);
        unsigned klt[8], vtt[8];
        LAS unsigned char* const kend_p = lds + KEND + (16 * sb) * ROWD + d * 2;
        LAS unsigned char* const qt_p = lds + QT + (16 * sb) * ROWD + d * 2;
#pragma unroll
        for (int r = 0; r < 16; r += 2) {
            float kl[2];
#pragma unroll
            for (int h2 = 0; h2 < 2; ++h2) { const int rr = r + h2;
                const float qv = bf2f(rq[rr]), kend = (1.0f - fx[rr]) * bk[rr], qe = qv * e1[rr];
                kl[h2] = kend * e_tail;
                const unsigned w = pg8::cvt_pk_bf16(kend, qe * e_head);
                *(LAS unsigned short*)(kend_p + rr * ROWD) = (unsigned short)w; *(LAS unsigned short*)(qt_p + rr * ROWD) = (unsigned short)(w >> 16);
                const float qd = qv * __builtin_amdgcn_rcpf(fmaxf(bk[rr], 1e-30f));
                if (sb == 0) { *(LAS unsigned short*)(lds + QJ + (0 + rr) * ROWD + d * 2) = (unsigned short)pg8::cvt_pk_bf16(qd, 0.f); }
                else if (sb == 1) { const unsigned u = pg8::cvt_pk_bf16(qe * Fj[0], qd);
                    *(LAS unsigned short*)(lds + QJ + (16 + rr) * ROWD + d * 2) = (unsigned short)u; *(LAS unsigned short*)(lds + QJ + (64 + rr) * ROWD + d * 2) = (unsigned short)(u >> 16); }
                else if (sb == 2) { const unsigned u = pg8::cvt_pk_bf16(qe * Fj[0], qe * Fj[1]), u2 = pg8::cvt_pk_bf16(qd, 0.f);
                    *(LAS unsigned short*)(lds + QJ + (32 + rr) * ROWD + d * 2) = (unsigned short)u; *(LAS unsigned short*)(lds + QJ + (64 + 16 + rr) * ROWD + d * 2) = (unsigned short)(u >> 16);
                    *(LAS unsigned short*)(lds + QJ + (112 + rr) * ROWD + d * 2) = (unsigned short)u2; }
                else { const unsigned u = pg8::cvt_pk_bf16(qe * Fj[0], qe * Fj[1]), u2 = pg8::cvt_pk_bf16(qe * Fj[2], qd);
                    *(LAS unsigned short*)(lds + QJ + (48 + rr) * ROWD + d * 2) = (unsigned short)u; *(LAS unsigned short*)(lds + QJ + (64 + 32 + rr) * ROWD + d * 2) = (unsigned short)(u >> 16);
                    *(LAS unsigned short*)(lds + QJ + (112 + 16 + rr) * ROWD + d * 2) = (unsigned short)u2; *(LAS unsigned short*)(lds + QJ + (144 + rr) * ROWD + d * 2) = (unsigned short)(u2 >> 16); }
            }
            klt[r >> 1] = pg8::cvt_pk_bf16(kl[0], kl[1]); vtt[r >> 1] = (unsigned)rv[r] | ((unsigned)rv[r + 1] << 16);
        }
        { LAS v4u* kp = (LAS v4u*)(lds + KLT + d * ROWT + sb * 32); kp[0] = (v4u){klt[0], klt[1], klt[2], klt[3]}; kp[1] = (v4u){klt[4], klt[5], klt[6], klt[7]};
          LAS v4u* vp = (LAS v4u*)(lds + VT + d * ROWT + sb * 32); vp[0] = (v4u){vtt[0], vtt[1], vtt[2], vtt[3]}; vp[1] = (v4u){vtt[4], vtt[5], vtt[6], vtt[7]}; }
        WG_SYNC();
        v2u gate[4];
#pragma unroll
        for (int tt = 0; tt < 4; ++tt) gate[tt] = *(const GAS v2u*)(ZC + (size_t)(row0 + 64 * c + 16 * tt + fr) * DINC + 6144 + h * 128 + 16 * wave + 4 * fq);
        asm volatile("" ::: "memory");
        { const int cn = c + 1 < nch ? c + 1 : c;
          load_raw(rq, rg, rv, ZC + (size_t)(row0 + 64 * cn + 16 * sb) * DINC + h * 128, d); }
#pragma unroll
        for (int rep = 0; rep < 2; ++rep) {
            const int task = wave + 8 * rep;
            if (task < 12) {
                int ti, tj; bool zero = false;
                switch (task) { case 0: ti = 0; tj = 0; break; case 1: ti = 1; tj = 0; break; case 2: ti = 1; tj = 1; break; case 3: ti = 2; tj = 0; break; case 4: ti = 2; tj = 1; break; case 5: ti = 2; tj = 2; break;
                                case 6: ti = 3; tj = 0; break; case 7: ti = 3; tj = 1; break; case 8: ti = 3; tj = 2; break; case 9: ti = 3; tj = 3; break; case 10: ti = 0; tj = 1; zero = true; break; default: ti = 2; tj = 3; zero = true; break; }
                f32x4 sacc = (f32x4){0.f, 0.f, 0.f, 0.f};
                if (!zero) {
                    const int rowb = (tj == 0 ? 0 : tj == 1 ? 64 : tj == 2 ? 112 : 144) + 16 * (ti - tj);
#pragma unroll
                    for (int ks = 0; ks < 4; ++ks) { const bf16x8 af = *(const LAS bf16x8*)(lds + KEND + (16 * tj + fr) * ROWD + ks * 64 + fq * 16);
                        const bf16x8 bfm = *(const LAS bf16x8*)(lds + QJ + (rowb + fr) * ROWD + ks * 64 + fq * 16);
                        sacc = __builtin_amdgcn_mfma_f32_16x16x32_bf16(af, bfm, sacc, 0, 0, 0); }
                    if (ti == tj) {
#pragma unroll
                        for (int e = 0; e < 4; ++e) if (4 * fq + e > fr) sacc[e] = 0.f; }
                }
                v2u w; w.x = pg8::cvt_pk_bf16(sacc[0], sacc[1]); w.y = pg8::cvt_pk_bf16(sacc[2], sacc[3]);
                *(LAS v2u*)(lds + SC + (16 * ti + fr) * ROWT + (16 * tj + 4 * fq) * 2) = w;
            }
        }
        f32x4 oacc[4];
#pragma unroll
        for (int tt = 0; tt < 4; ++tt) oacc[tt] = (f32x4){0.f, 0.f, 0.f, 0.f};
#pragma unroll
        for (int kp = 0; kp < 4; ++kp) {
            v4u w; w.x = pg8::cvt_pk_bf16(S[2 * kp][0], S[2 * kp][1]); w.y = pg8::cvt_pk_bf16(S[2 * kp][2], S[2 * kp][3]); w.z = pg8::cvt_pk_bf16(S[2 * kp + 1][0], S[2 * kp + 1][1]); w.w = pg8::cvt_pk_bf16(S[2 * kp + 1][2], S[2 * kp + 1][3]);
            const bf16x8 af = __builtin_bit_cast(bf16x8, w);
#pragma unroll
            for (int tt = 0; tt < 4; ++tt) { const LAS unsigned char* qp = lds + QT + (16 * tt + fr) * ROWD + (32 * kp + 4 * fq) * 2;
                const v2u lo = *(const LAS v2u*)qp, hi = *(const LAS v2u*)(qp + 32); const v4u qw = {lo.x, lo.y, hi.x, hi.y};
                oacc[tt] = __builtin_amdgcn_mfma_f32_16x16x32_bf16(af, __builtin_bit_cast(bf16x8, qw), oacc[tt], 0, 0, 0); }
        }
        bf16x8 vf[2];
#pragma unroll
        for (int ks = 0; ks < 2; ++ks) vf[ks] = *(const LAS bf16x8*)(lds + VT + (16 * wave + fr) * ROWT + ks * 64 + fq * 16);
#pragma unroll
        for (int a = 0; a < 8; ++a) { const f32x4 dec = *(const LAS f32x4*)(lds + EAL + (16 * a + 4 * fq) * 4); S[a] = S[a] * dec;
#pragma unroll
            for (int ks = 0; ks < 2; ++ks) { const bf16x8 af = *(const LAS bf16x8*)(lds + KLT + (16 * a + fr) * ROWT + ks * 64 + fq * 16);
                S[a] = __builtin_amdgcn_mfma_f32_16x16x32_bf16(af, vf[ks], S[a], 0, 0, 0); } }
        WG_SYNC();
#pragma unroll
        for (int tt = 0; tt < 4; ++tt) {
#pragma unroll
            for (int ks = 0; ks < 2; ++ks) if (ks == 0 || tt >= 2) { const bf16x8 bfm = *(const LAS bf16x8*)(lds + SC + (16 * tt + fr) * ROWT + ks * 64 + fq * 16);
                oacc[tt] = __builtin_amdgcn_mfma_f32_16x16x32_bf16(vf[ks], bfm, oacc[tt], 0, 0, 0); }
            float q2 = (oacc[tt][0] * oacc[tt][0] + oacc[tt][1] * oacc[tt][1]) + (oacc[tt][2] * oacc[tt][2] + oacc[tt][3] * oacc[tt][3]);
            q2 += __shfl_xor(q2, 16); q2 += __shfl_xor(q2, 32);
            if (fq == 0) ssq[wave * 64 + 16 * tt + fr] = q2;
        }
        WG_SYNC();
#pragma unroll
        for (int tt = 0; tt < 4; ++tt) { float q2 = 0.f;
#pragma unroll
            for (int w = 0; w < 8; ++w) q2 += ssq[w * 64 + 16 * tt + fr];
            const float rstd = __builtin_amdgcn_rsqf(q2 * (1.f / 128.f) + EPS);
            v2u w; w.x = pg8::cvt_pk_bf16(oacc[tt][0] * rstd * gov[0] * bflo(gate[tt].x), oacc[tt][1] * rstd * gov[1] * bfhi(gate[tt].x)); w.y = pg8::cvt_pk_bf16(oacc[tt][2] * rstd * gov[2] * bflo(gate[tt].y), oacc[tt][3] * rstd * gov[3] * bfhi(gate[tt].y));
            *(GAS v2u*)(OB + (size_t)(row0 + 64 * c + 16 * tt + fr) * D + h * 128 + 16 * wave + 4 * fq) = w; }
    }
#pragma unroll
    for (int a = 0; a < 8; ++a)
#pragma unroll
        for (int e = 0; e < 4; ++e) sout[(16 * a + 4 * fq + e) * 128 + 16 * wave + fr] = S[a][e];
    __syncthreads();
}
}

__device__ __forceinline__ void load8f(const bf16* p, float (&v)[8]) { const v4u w = *(const GAS v4u*)p; v[0] = bflo(w.x); v[1] = bfhi(w.x); v[2] = bflo(w.y); v[3] = bfhi(w.y); v[4] = bflo(w.z); v[5] = bfhi(w.z); v[6] = bflo(w.w); v[7] = bfhi(w.w); }
__device__ __forceinline__ void cu_row(const bf16* zrow, int c0, float (&cu)[8]) { float a[8], b[8]; load8f(zrow + 1024 + c0, a); load8f(zrow + 2048 + c0, b);
#pragma unroll
    for (int j = 0; j < 8; ++j) cu[j] = a[j] * b[j]; }
__device__ __forceinline__ void mixa_conv_strip(int m0, int e, const bf16* ZA, const float* cache_conv, const float* w_conv, bf16* CAT, float* out, int lane) {
    const bool smp = m0 >= MP; const int mm = smp ? m0 - MP : m0;
    const int b = smp ? mm >> 6 : mm >> 11, t0 = smp ? mm & 63 : mm & 2047, T = smp ? DSEQ : SEQ;
    const float* wc = w_conv + (size_t)e * 3 * DCONV;
#pragma unroll
    for (int half = 0; half < 2; ++half) {
        const int c0 = 512 * half + 8 * lane;
        float cu1[8], cu2[8], w0[8], w1[8], w2[8];
#pragma unroll
        for (int j = 0; j < 8; ++j) { w0[j] = wc[c0 + j]; w1[j] = wc[DCONV + c0 + j]; w2[j] = wc[2 * DCONV + c0 + j]; }
        if (t0 >= 2) { cu_row(ZA + (size_t)(m0 - 1) * DINA_P, c0, cu1); cu_row(ZA + (size_t)(m0 - 2) * DINA_P, c0, cu2); }
        else {
#pragma unroll
            for (int j = 0; j < 8; ++j) { cu1[j] = smp ? cache_conv[((size_t)(e * DB + b) * 2 + 1) * DCONV + c0 + j] : 0.f; cu2[j] = smp ? cache_conv[((size_t)(e * DB + b) * 2 + 0) * DCONV + c0 + j] : 0.f; } }
#pragma unroll
        for (int r = 0; r < 4; ++r) { const int m = m0 + r, t = t0 + r; const bf16* zrow = ZA + (size_t)m * DINA_P;
            float gb[8], cu0[8], y[8];
            load8f(zrow + c0, gb); cu_row(zrow, c0, cu0);
#pragma unroll
            for (int j = 0; j < 8; ++j) y[j] = gb[j] * (w0[j] * cu2[j] + w1[j] * cu1[j] + w2[j] * cu0[j]);
            v4u w; w.x = pk2(y[0], y[1]); w.y = pk2(y[2], y[3]); w.z = pk2(y[4], y[5]); w.w = pk2(y[6], y[7]);
            *(GAS v4u*)(CAT + (size_t)m * D + c0) = w;
            if (t >= T - 2) { float* cs = out + (smp ? O_CONVS + ((size_t)(e * DB + b) * 2 + (t - (T - 2))) * DCONV : O_CONVP + ((size_t)(e * NB + b) * 2 + (t - (T - 2))) * DCONV) + c0;
                *(GAS f32x4*)cs = (f32x4){cu0[0], cu0[1], cu0[2], cu0[3]}; *(GAS f32x4*)(cs + 4) = (f32x4){cu0[4], cu0[5], cu0[6], cu0[7]}; }
#pragma unroll
            for (int j = 0; j < 8; ++j) { cu2[j] = cu1[j]; cu1[j] = cu0[j]; }
        }
    }
}
__device__ __forceinline__ void mixa_row(int m, int e, const bf16* ZA, const float* g_q, const float* g_kv, const float* rope,
                                         bf16* CQN, bf16* KVIN, bf16* KPEB, float* out, int lane) {
    const bool smp = m >= MP; const int mm = smp ? m - MP : m;
    const int b = smp ? mm >> 6 : mm >> 11, t = smp ? mm & 63 : mm & 2047;
    const int kvrow = smp ? MP + b * KVS + PAST + t : m, pos = smp ? PAST + t : t;
    const bf16* zrow = ZA + (size_t)m * DINA_P;
    {
        float v[8]; load8f(zrow + 3072 + 8 * lane, v); float s = 0.f;
#pragma unroll
        for (int j = 0; j < 8; ++j) s += v[j] * v[j];
        const float rstd = 1.0f / sqrtf(wave_sum(s) * (1.f / QL) + EPS); const float* g = g_q + e * QL + 8 * lane;
        v4u w; w.x = pk2(v[0] * rstd * g[0], v[1] * rstd * g[1]); w.y = pk2(v[2] * rstd * g[2], v[3] * rstd * g[3]); w.z = pk2(v[4] * rstd * g[4], v[5] * rstd * g[5]); w.w = pk2(v[6] * rstd * g[6], v[7] * rstd * g[7]);
        *(GAS v4u*)(CQN + (size_t)m * QL + 8 * lane) = w;
    }
    {
        float v[8]; load8f(zrow + 3584 + 8 * lane, v); float s = 0.f;
#pragma unroll
        for (int j = 0; j < 8; ++j) s += v[j] * v[j];
        const float rstd = 1.0f / sqrtf(wave_sum(s) * (1.f / KVL) + EPS); const float* g = g_kv + e * KVL + 8 * lane;
#pragma unroll
        for (int j = 0; j < 8; ++j) v[j] = v[j] * rstd * g[j];
        v4u w; w.x = pk2(v[0], v[1]); w.y = pk2(v[2], v[3]); w.z = pk2(v[4], v[5]); w.w = pk2(v[6], v[7]);
        *(GAS v4u*)(KVIN + (size_t)kvrow * KVL + 8 * lane) = w;
        float* co = out + (smp ? O_CKVS + ((size_t)(e * DB + b) * DSEQ + t) * KVL : O_CKVP + ((size_t)(e * NB + b) * SEQ + t) * KVL) + 8 * lane;
        *(GAS f32x4*)co = (f32x4){v[0], v[1], v[2], v[3]}; *(GAS f32x4*)(co + 4) = (f32x4){v[4], v[5], v[6], v[7]};
    }
    if (lane < 32) {
        const float x1 = bf2f(zrow[4096 + lane]), x2 = bf2f(zrow[4096 + 32 + lane]);
        const float c = rope[(size_t)pos * 64 + 2 * lane], s = rope[(size_t)pos * 64 + 2 * lane + 1];
        const float r1 = x1 * c - x2 * s, r2 = x1 * s + x2 * c;
        float* ko = out + (smp ? O_KPES + ((size_t)(e * DB + b) * DSEQ + t) * ROPE : O_KPEP + ((size_t)(e * NB + b) * SEQ + t) * ROPE);
        ko[lane] = r1; ko[32 + lane] = r2;
        KPEB[(size_t)kvrow * ROPE + lane] = (bf16)f2bf(r1); KPEB[(size_t)kvrow * ROPE + 32 + lane] = (bf16)f2bf(r2);
    }
}

#ifndef REP_ATT
#define REP_ATT 1
#endif
#ifndef REP_GLA
#define REP_GLA 1
#endif
#ifndef REP_MIXA
#define REP_MIXA 1
#endif
#ifndef REP_NORM
#define REP_NORM 1
#endif
#ifndef REP_PRO
#define REP_PRO 1
#endif
#ifndef REP_GU
#define REP_GU 1
#endif
#ifndef STAG_ON
#define STAG_ON 0
#endif
#ifndef STAG_GU
#define STAG_GU 100
#endif
#ifndef STAG_RES
#define STAG_RES 250
#endif
#ifndef STAG_IN
#define STAG_IN 150
#endif
#ifndef WGM_GU
#define WGM_GU 4
#endif
#ifndef MK_ONE_LAUNCH
#define MK_ONE_LAUNCH 1
#endif
constexpr int N_PHASES = 1 + 8 * 2 + 2 * 5 + 2 * 3 + 1;

#define PH_LOCALS \
    const CAS Args* ap_ = (const CAS Args*)__builtin_amdgcn_kernarg_segment_ptr(); asm volatile("" : "+s"(ap_)); const CAS Args& args = *ap_;   \
    int tid = threadIdx.x; asm volatile("" : "+v"(tid)); const int lane = tid & 63, wave = __builtin_amdgcn_readfirstlane(tid >> 6); \
    GAS unsigned char* ws_ = (GAS unsigned char*)args.ws; asm volatile("" : "+s"(ws_)); unsigned char* ws = (unsigned char*)ws_;   \
    GAS float* X_ = (GAS float*)args.out; asm volatile("" : "+s"(X_)); float* X = (float*)X_; \
    int G = gridDim.x; asm volatile("" : "+s"(G)); int bid = blockIdx.x; asm volatile("" : "+s"(bid)); \
    const int gw = bid * NWAVES + wave, NGW = G * NWAVES; LAS unsigned char* lds = (LAS unsigned char*)lds_raw; \
    bf16* XN = (bf16*)(ws + WS_XN); bf16* CAT = (bf16*)(ws + WS_CAT); pg8::ssq_t* SSQ = (pg8::ssq_t*)(ws + WS_SS); (void)lane; (void)gw; (void)NGW; (void)XN; (void)CAT; (void)SSQ; (void)X; (void)lds;

#define PH_L int lq_ = l; asm volatile("" : "+s"(lq_)); const int l = lq_; const int e = l >> 1, o = l >> 1; (void)e; (void)o;
__global__ void __launch_bounds__(NTHR, 2) mega_fwd(Args kargs) {
    extern __shared__ __attribute__((aligned(16))) unsigned char lds_raw[];
    XcdBarrier bar;
    {
        volatile LAS unsigned* MISC = (volatile LAS unsigned*)((LAS unsigned char*)lds_raw + MISC_OFF);
        if (threadIdx.x < 32) MISC[threadIdx.x] = 0u;
        __syncthreads();
        bar.bar = (unsigned*)(kargs.ws + WS_CTL) + CW_BAR; bar.x = 0; bar.st = nullptr;
        if (MK_ONE_LAUNCH) bar = xcd_barrier_post((unsigned*)(kargs.ws + WS_CTL) + CW_BAR, MISC + 8);
    }
    const int lo = kargs.ph_lo, hi = kargs.ph_hi;
    int ph = 0;
#define IN_PHASE (ph >= lo && ph < hi)
#define STAGGER(T_) do { if (STAG_ON) { const unsigned long long t0_ = __builtin_amdgcn_s_memrealtime(); const unsigned long long d_ = (unsigned long long)((blockIdx.x >> 3) & 3u) * (T_); while (__builtin_amdgcn_s_memrealtime() - t0_ < d_) __builtin_amdgcn_s_sleep(2); } } while (0)
#define END_PHASE do { if (MK_ONE_LAUNCH && ph + 1 < hi && ph + 1 < N_PHASES) { XcdBarrier b2_ = bar; GAS unsigned* bb_ = (GAS unsigned*)bar.bar; asm volatile("" : "+s"(bb_)); b2_.bar = (unsigned*)bb_; asm volatile("" : "+s"(b2_.x)); xcd_barrier(b2_); } ++ph; } while (0)

    if (IN_PHASE) {
        PH_LOCALS
        cv_group(args.in, ws, 0, (unsigned*)(ws + WS_CTL) + CW_CONV, lds + RING_OFF + wave * 16384, lane);
        const size_t gt = (size_t)bid * NTHR + tid, GT = (size_t)G * NTHR;
        for (size_t i = gt; i < (size_t)2 * (DINA_P - DINA) * D / 8; i += GT) { const size_t e = i / ((DINA_P - DINA) * D / 8), j = i % ((DINA_P - DINA) * D / 8);
            *(GAS v4u*)((bf16*)(ws + WS_WINA) + e * DINA_P * D + (size_t)DINA * D + j * 8) = (v4u){0u, 0u, 0u, 0u}; }
        for (int m = gw; m < M; m += NGW) x_row_init(m < MP ? args.in[I_XP] + (size_t)m * D : args.in[I_XS] + (size_t)(m - MP) * D, XN + (size_t)m * D, SSQ + (size_t)m * 8, lane);
        for (size_t i = gt; i < (size_t)KVS * 32; i += GT) { const int pos = (int)(i >> 5), k = (int)(i & 31); const double inv = exp(-(double)k * (9.210340371976184 / 32.0)), ang = (double)pos * inv;
            float* rp = (float*)(ws + WS_ROPE) + 2 * i; rp[0] = (float)cos(ang); rp[1] = (float)sin(ang); }
        for (size_t i = gt; i < 2048; i += GT) { const float a = args.in[I_LB][i], b2 = args.in[I_LB][2048 + i]; float* lbp = (float*)(ws + WS_LB);
            lbp[i] = 0.f; lbp[2048 + i] = 1.0f / (1.0f + expf(a - b2)); }
    }
    END_PHASE;

#define FFN_STEP(F_) { \
        if (IN_PHASE) { PH_LOCALS PH_L const int inst = (F_) * 4 + l; pg8::Gemm g{XN, (const bf16*)(ws + WS_WGU) + (size_t)inst * 2 * DFF * D, M, 2 * DFF, D, D, D}; pg8::StaticOrder S; S.init(M, 2 * DFF, G, bid, WGM_GU); \
            pg8::EpiSwiGLU E{(bf16*)(ws + WS_H), DFF, SSQ + (size_t)(3 * l + 2 * (F_)) * M * 8}; STAGGER(STAG_GU); for (int rep_ = 0; rep_ < REP_GU; ++rep_) pg8::gemm_phase<pg8::EpiSwiGLU, pg8::StaticOrder, true, true>(lds + RING_OFF, g, S, E); } \
        END_PHASE; \
        if (IN_PHASE) { PH_LOCALS PH_L const int inst = (F_) * 4 + l; pg8::Gemm g{(const bf16*)(ws + WS_H), (const bf16*)(ws + WS_WD) + (size_t)inst * D * DFF, M, D, DFF, DFF, DFF}; pg8::StaticOrder S; S.init(M, D, G, bid); \
            const int site = 3 * l + 2 * (F_) + 1; pg8::EpiResidNorm E{XN, SSQ + (size_t)site * M * 8, D, 0.5f, (PG8_LAS float*)(lds + EPI_P_OFF)}; STAGGER(STAG_RES); pg8::gemm_phase<pg8::EpiResidNorm, pg8::StaticOrder, true, true, true, true>(lds + RING_OFF, g, S, E); \
            const int cg = 1 + 2 * l + (F_); if (cg < 8) cv_group(args.in, ws, cg, (unsigned*)(ws + WS_CTL) + CW_CONV + 64 * cg, lds + RING_OFF + wave * 16384, lane, (F_) ? 0 : 1); } \
        END_PHASE; }

    for (int l = 0; l < DEPTH; ++l) {
        FFN_STEP(0)
        if ((l & 1) == 0) {
            const int e = l >> 1;
            if (IN_PHASE) { PH_LOCALS PH_L pg8::Gemm g{XN, (const bf16*)(ws + WS_WINA) + (size_t)e * DINA_P * D, M, DINA_P, D, D, D}; pg8::StaticOrder S; S.init(M, DINA_P, G, bid);
                pg8::EpiStore E{(bf16*)(ws + WS_ZA), DINA_P, SSQ + (size_t)(3 * l + 1) * M * 8}; STAGGER(STAG_IN); pg8::gemm_phase<pg8::EpiStore, pg8::StaticOrder, true, true>(lds + RING_OFF, g, S, E); }
            END_PHASE;
            if (IN_PHASE) { PH_LOCALS PH_L
                bf16* ZA = (bf16*)(ws + WS_ZA); bf16* CQN = (bf16*)(ws + WS_CQN); bf16* KVIN = (bf16*)(ws + WS_KVIN); bf16* KPEB = (bf16*)(ws + WS_KPEB); const float* rope = (const float*)(ws + WS_ROPE);
                for (int rep = 0; rep < REP_MIXA; ++rep)
                for (int st = gw; st < M / 4; st += NGW) { mixa_conv_strip(4 * st, e, ZA, args.in[I_CCONV], args.in[I_WCONV], CAT, X, lane);
                    for (int r = 0; r < 4; ++r) mixa_row(4 * st + r, e, ZA, args.in[I_GQ], args.in[I_GKV], rope, CQN, KVIN, KPEB, X, lane); }
                for (int r = gw; r < DB * PAST; r += NGW) { const int b = r >> 12, s = r & 4095; const size_t kvrow = (size_t)MP + (size_t)b * KVS + s;
                    const float* src = args.in[I_CCKV] + ((size_t)(e * DB + b) * PAST + s) * KVL + 8 * lane; const f32x4 a = *(const GAS f32x4*)src, c = *(const GAS f32x4*)(src + 4);
                    v4u w; w.x = pk2(a.x, a.y); w.y = pk2(a.z, a.w); w.z = pk2(c.x, c.y); w.w = pk2(c.z, c.w); *(GAS v4u*)(KVIN + kvrow * KVL + 8 * lane) = w;
                    KPEB[kvrow * ROPE + lane] = (bf16)f2bf(args.in[I_CKPE][((size_t)(e * DB + b) * PAST + s) * ROPE + lane]); }
            }
            END_PHASE;
            if (IN_PHASE) { PH_LOCALS PH_L
                { pg8::Gemm g{(const bf16*)(ws + WS_CQN), (const bf16*)(ws + WS_WUQ) + (size_t)e * 1536 * QL, M, 1536, QL, QL, QL}; pg8::StaticOrder S; S.init(M, 1536, G, bid);
                  pg8::EpiStore E{(bf16*)(ws + WS_QB), 1536, nullptr}; pg8::gemm_phase<pg8::EpiStore, pg8::StaticOrder, true, true>(lds + RING_OFF, g, S, E); }
                { pg8::Gemm g{(const bf16*)(ws + WS_KVIN), (const bf16*)(ws + WS_WUKV) + (size_t)e * 2048 * KVL, KVROWS, 1024, KVL, KVL, KVL}; pg8::StaticOrder S; S.init(KVROWS, 1024, G, bid);
                  pg8::EpiStore E{(bf16*)(ws + WS_KNOPE), 1024, nullptr}; pg8::gemm_phase<pg8::EpiStore, pg8::StaticOrder, true, true>(lds + RING_OFF, g, S, E); }
                { pg8::Gemm g{(const bf16*)(ws + WS_WUKV) + (size_t)e * 2048 * KVL + (size_t)1024 * KVL, (const bf16*)(ws + WS_KVIN), 1024, KVROWS, KVL, KVL, KVL}; pg8::StaticOrder S; S.init(1024, KVROWS, G, bid);
                  pg8::EpiStore E{(bf16*)(ws + WS_VT), KVROWS, nullptr}; pg8::gemm_phase<pg8::EpiStore, pg8::StaticOrder, true, true>(lds + RING_OFF, g, S, E); }
            }
            END_PHASE;
            if (IN_PHASE) { PH_LOCALS PH_L
                for (int rep = 0; rep < REP_ATT; ++rep) {
                unsigned* ctr = (unsigned*)(ws + WS_CTL) + CW_ATTN + 64 * e + 1024 * rep;
                LAS unsigned* uw = (LAS unsigned*)(lds + att::UNIT_OFF);
                for (;;) {
                    if (tid == 0) *uw = atomicAdd(ctr, 1u);
                    LDS_WAIT(); __syncthreads();
                    const int unit = __builtin_amdgcn_readfirstlane((int)*uw);
                    __syncthreads();
                    if (unit >= att::NUNITS) break;
                    int tid_u = tid; asm volatile("" : "+v"(tid_u)); const int lane_u = tid_u & 63;
                    if (unit < DB * HEADS) att::attn_unit<false>(unit, lds, (const bf16*)(ws + WS_QB), (const bf16*)(ws + WS_KNOPE), (const bf16*)(ws + WS_KPEB), (const bf16*)(ws + WS_VT), (const float*)(ws + WS_ROPE), CAT, tid_u, wave, lane_u);
                    else att::attn_unit<true>(unit, lds, (const bf16*)(ws + WS_QB), (const bf16*)(ws + WS_KNOPE), (const bf16*)(ws + WS_KPEB), (const bf16*)(ws + WS_VT), (const float*)(ws + WS_ROPE), CAT, tid_u, wave, lane_u);
                }
                }
            }
            END_PHASE;
            if (IN_PHASE) { PH_LOCALS PH_L pg8::Gemm g{CAT, (const bf16*)(ws + WS_WOA) + (size_t)e * D * D, M, D, D, D, D}; pg8::StaticOrder S; S.init(M, D, G, bid);
                pg8::EpiResidNorm E{XN, SSQ + (size_t)(3 * l + 2) * M * 8, D, 1.0f, (PG8_LAS float*)(lds + EPI_P_OFF)}; STAGGER(STAG_RES); pg8::gemm_phase<pg8::EpiResidNorm, pg8::StaticOrder, true, true>(lds + RING_OFF, g, S, E);
                cv_group(args.in, ws, 1 + 2 * l, (unsigned*)(ws + WS_CTL) + CW_CONV + 64 * (8 + l), lds + RING_OFF + wave * 16384, lane, 2); }
            END_PHASE;
        } else {
            const int o = l >> 1;
            if (IN_PHASE) { PH_LOCALS PH_L pg8::Gemm g{XN, (const bf16*)(ws + WS_WINC) + (size_t)o * DINC * D, M, DINC, D, D, D}; pg8::StaticOrder S; S.init(M, DINC, G, bid);
                pg8::EpiGla E{(bf16*)(ws + WS_ZC), DINC, (const float*)(ws + WS_LB) + o * 2048, SSQ + (size_t)(3 * l + 1) * M * 8}; STAGGER(STAG_IN); pg8::gemm_phase<pg8::EpiGla, pg8::StaticOrder, true, true>(lds + RING_OFF, g, S, E); }
            END_PHASE;
            if (IN_PHASE) { PH_LOCALS PH_L
                for (int rep = 0; rep < REP_GLA; ++rep) {
                unsigned* ctr = (unsigned*)(ws + WS_CTL) + CW_GLA + 64 * o + 1024 * rep;
                LAS unsigned* uw = (LAS unsigned*)(lds + gla::UNIT);
                for (;;) {
                    if (tid == 0) *uw = atomicAdd(ctr, 1u);
                    LDS_WAIT(); __syncthreads();
                    const int unit = __builtin_amdgcn_readfirstlane((int)*uw);
                    __syncthreads();
                    if (unit >= gla::NUNITS) break;
                    gla::gla_unit(unit, lds, (const bf16*)(ws + WS_ZC), args.in[I_SHG] + (size_t)o * DB * HGH * HGD * HGD, args.in[I_GO] + o * HGD, CAT,
                                  X + O_HGP + (size_t)o * NB * HGH * HGD * HGD, X + O_HGS + (size_t)o * DB * HGH * HGD * HGD, tid, wave, lane);
                }
                }
            }
            END_PHASE;
            if (IN_PHASE) { PH_LOCALS PH_L pg8::Gemm g{CAT, (const bf16*)(ws + WS_WOC) + (size_t)o * D * D, M, D, D, D, D}; pg8::StaticOrder S; S.init(M, D, G, bid);
                pg8::EpiResidNorm E{XN, SSQ + (size_t)(3 * l + 2) * M * 8, D, 1.0f, (PG8_LAS float*)(lds + EPI_P_OFF)}; STAGGER(STAG_RES); pg8::gemm_phase<pg8::EpiResidNorm, pg8::StaticOrder, true, true>(lds + RING_OFF, g, S, E);
                cv_group(args.in, ws, 1 + 2 * l, (unsigned*)(ws + WS_CTL) + CW_CONV + 64 * (8 + l), lds + RING_OFF + wave * 16384, lane, 2); }
            END_PHASE;
        }
        FFN_STEP(1)
    }
#undef FFN_STEP
    if (IN_PHASE) { PH_LOCALS
        const float* gain = args.in[I_NFIN]; const pg8::ssq_t* ssf = SSQ + (size_t)12 * M * 8;
        for (int m = gw; m < M; m += NGW) { const GAS v2u* xr = (const GAS v2u*)(XN + (size_t)m * D) + lane; GAS f32x4* yo = (GAS f32x4*)(X + (size_t)m * D) + lane; const GAS f32x4* gr = (const GAS f32x4*)gain + lane;
            const float rstd = pg8::row_rstd(ssf, m);
#pragma unroll
            for (int j = 0; j < 8; ++j) { const v2u w = xr[64 * j]; const f32x4 g = gr[64 * j]; yo[64 * j] = (f32x4){bflo(w.x) * rstd * g.x, bfhi(w.x) * rstd * g.y, bflo(w.y) * rstd * g.z, bfhi(w.y) * rstd * g.w}; } }
    }
    ++ph;
#undef IN_PHASE
#undef END_PHASE
}

extern "C" void kernel_launch(void* const* d_in, const int* in_sizes, int n_in, void* d_out, int out_size, void* d_ws, size_t ws_size, hipStream_t stream) {
    static int grid = 0;
    if (grid == 0) {
        if (n_in != N_IN || (size_t)out_size != O_END || ws_size < WS_TOTAL) { fprintf(stderr, "kernel_launch: unexpected shapes (n_in %d, out %d, ws %zu); nothing launched\n", n_in, out_size, ws_size); grid = -1; return; }
        int dev = 0, cus = 0, per_cu = 0;
        if (hipGetDevice(&dev) != hipSuccess || hipDeviceGetAttribute(&cus, hipDeviceAttributeMultiprocessorCount, dev) != hipSuccess) { grid = -1; return; }
        if (hipFuncSetAttribute((const void*)mega_fwd, hipFuncAttributeMaxDynamicSharedMemorySize, LDS_BYTES) != hipSuccess) { fprintf(stderr, "kernel_launch: hipFuncSetAttribute failed\n"); grid = -1; return; }
        if (hipOccupancyMaxActiveBlocksPerMultiprocessor(&per_cu, (const void*)mega_fwd, NTHR, LDS_BYTES) != hipSuccess || per_cu < 1) { fprintf(stderr, "kernel_launch: occupancy query says %d\n", per_cu); (void)hipGetLastError(); grid = -1; return; }
        grid = cus;
    }
    if (grid < 0) return;
    if (hipMemsetAsync((char*)d_ws + WS_CTL, 0, CTL_ZERO_BYTES, stream) != hipSuccess) return;
    Args a{};
    for (int i = 0; i < N_IN; ++i) a.in[i] = (const float*)d_in[i];
    a.out = (float*)d_out; a.ws = (unsigned char*)d_ws;
#if MK_ONE_LAUNCH
    a.ph_lo = 0; a.ph_hi = N_PHASES;
    hipLaunchKernelGGL(mega_fwd, dim3(grid), dim3(NTHR), LDS_BYTES, stream, a);
#else
    for (int p = 0; p < N_PHASES; ++p) { a.ph_lo = p; a.ph_hi = p + 1; hipLaunchKernelGGL(mega_fwd, dim3(grid), dim3(NTHR), LDS_BYTES, stream, a); }
#endif
}
```
